# Optimizing an MI355X kernel written in HIP

```python
import jax, jax.numpy as jnp
from jax import lax
import numpy as np

D_MODEL = 1024
BATCH = 32
SEQ = 2048
DEPTH = 2

CHUNK = 64
N_MIXERS = 2
N_SB_LAYERS = (DEPTH + 1) // 2
N_TM_LAYERS = DEPTH // 2
SB_HEADS = 16
SB_HEAD_DIM = D_MODEL // SB_HEADS
SB_QBLOCK = 128
TM_CHUNK = 128
TM_GROUPS = 8
TM_GROUP_DIM = D_MODEL // TM_GROUPS
D_FF = -(-8 * D_MODEL // (3 * 256)) * 256
EPS = 1e-6

kernel_name = "hybrid_stickbreak_tokenmlp_swiglu"


def rms_norm(x, g):
    xf = x.astype(jnp.float32)
    y = xf * lax.rsqrt(jnp.mean(xf * xf, axis=-1, keepdims=True) + EPS)
    return (y * g.astype(jnp.float32)).astype(x.dtype)


def layer_norm(x, g):
    xf = x.astype(jnp.float32)
    mu = jnp.mean(xf, axis=-1, keepdims=True)
    xc = xf - mu
    y = xc * lax.rsqrt(jnp.mean(xc * xc, axis=-1, keepdims=True) + EPS)
    return (y * g.astype(jnp.float32)).astype(x.dtype)


def ada_modulation(c, w, b):
    m = jax.nn.silu(c) @ w + b
    shift, scale, gate = jnp.split(m, 3, axis=-1)
    return shift[:, None, :], scale[:, None, :], gate[:, None, :]


def stick_breaking_attention(q, k, v):
    S = q.shape[2]
    scale = SB_HEAD_DIM ** -0.5
    outs = []
    for qb in range(S // SB_QBLOCK):
        q0 = qb * SB_QBLOCK
        kend = q0 + SB_QBLOCK
        z = jnp.einsum('bhtd,bhsd->bhts', q[:, :, q0:kend], k[:, :, :kend]).astype(jnp.float32) * scale
        t_idx = q0 + jnp.arange(SB_QBLOCK)[:, None]
        s_idx = jnp.arange(kend)[None, :]
        before = s_idx < t_idx
        log_beta = jax.nn.log_sigmoid(z)
        log_1m = jnp.where(before, jax.nn.log_sigmoid(-z), 0.0)
        later = lax.cumsum(log_1m, axis=3, reverse=True) - log_1m
        a = jnp.where(before, jnp.exp(log_beta + later), 0.0)
        outs.append(jnp.einsum('bhts,bhsd->bhtd', a.astype(v.dtype), v[:, :, :kend]))
    return jnp.concatenate(outs, axis=2)


def stick_breaking_mixer(h, w_qkv, w_o):
    B, S, D = h.shape
    qkv = (h @ w_qkv).reshape(B, S, 3, SB_HEADS, SB_HEAD_DIM)
    q = qkv[:, :, 0].transpose(0, 2, 1, 3)
    k = qkv[:, :, 1].transpose(0, 2, 1, 3)
    v = qkv[:, :, 2].transpose(0, 2, 1, 3)
    o = stick_breaking_attention(q, k, v)
    return o.transpose(0, 2, 1, 3).reshape(B, S, D) @ w_o


def token_mixing_mixer(h, w_in, ln_g, w_s, b_s, w_out):
    B, S, D = h.shape
    uv = jax.nn.gelu(h @ w_in)
    u, v = jnp.split(uv, 2, axis=-1)
    v = layer_norm(v, ln_g)
    n = S // TM_CHUNK
    v = v.reshape(B, n, TM_CHUNK, TM_GROUPS, TM_GROUP_DIM)
    pos = jnp.arange(TM_CHUNK)
    chunk_causal = (pos[:, None] // CHUNK) >= (pos[None, :] // CHUNK)
    ws = jnp.where(chunk_causal[None], w_s, 0.0).astype(v.dtype)
    sv = jnp.einsum('gts,bnsgc->bntgc', ws, v) + b_s.T[None, None, :, :, None]
    y = u * sv.reshape(B, S, D)
    return y @ w_out


def swiglu(h, w_gate, w_up, w_down):
    return (jax.nn.silu(h @ w_gate) * (h @ w_up)) @ w_down


def setup_inputs(seed: int = 0) -> dict:
    key = jax.random.key(seed)
    ks = jax.random.split(key, 24)
    D = D_MODEL

    def nrm(k, shape, s):
        return jax.random.normal(k, shape, jnp.float32) * s

    return {
        "x": nrm(ks[0], (BATCH, SEQ, D), 1.0),
        "c": nrm(ks[1], (BATCH, D), 1.0),
        "mix_ada_w": nrm(ks[2], (DEPTH, D, 3 * D), 0.5 * D ** -0.5),
        "mix_ada_b": nrm(ks[3], (DEPTH, 3 * D), 0.02),
        "mix_pre_g": 1.0 + nrm(ks[4], (DEPTH, D), 0.02),
        "mix_post_g": 1.0 + nrm(ks[5], (DEPTH, D), 0.02),
        "sb_w_qkv": nrm(ks[6], (N_SB_LAYERS, D, 3 * D), D ** -0.5),
        "sb_w_o": nrm(ks[7], (N_SB_LAYERS, D, D), D ** -0.5),
        "tm_w_in": nrm(ks[8], (N_TM_LAYERS, D, 2 * D), D ** -0.5),
        "tm_ln_g": 1.0 + nrm(ks[9], (N_TM_LAYERS, D), 0.02),
        "tm_w_s": nrm(ks[10], (N_TM_LAYERS, TM_GROUPS, TM_CHUNK, TM_CHUNK), TM_CHUNK ** -0.5),
        "tm_b_s": 1.0 + nrm(ks[11], (N_TM_LAYERS, TM_GROUPS, TM_CHUNK), 0.02),
        "tm_w_out": nrm(ks[12], (N_TM_LAYERS, D, D), D ** -0.5),
        "ffn_ada_w": nrm(ks[13], (DEPTH, D, 3 * D), 0.5 * D ** -0.5),
        "ffn_ada_b": nrm(ks[14], (DEPTH, 3 * D), 0.02),
        "ffn_pre_g": 1.0 + nrm(ks[15], (DEPTH, D), 0.02),
        "ffn_post_g": 1.0 + nrm(ks[16], (DEPTH, D), 0.02),
        "ffn_w_gate": nrm(ks[17], (DEPTH, D, D_FF), D ** -0.5),
        "ffn_w_up": nrm(ks[18], (DEPTH, D, D_FF), D ** -0.5),
        "ffn_w_down": nrm(ks[19], (DEPTH, D_FF, D), D_FF ** -0.5),
    }


def reference(x, c, mix_ada_w, mix_ada_b, mix_pre_g, mix_post_g, sb_w_qkv, sb_w_o,
              tm_w_in, tm_ln_g, tm_w_s, tm_b_s, tm_w_out, ffn_ada_w, ffn_ada_b,
              ffn_pre_g, ffn_post_g, ffn_w_gate, ffn_w_up, ffn_w_down):
    for i in range(DEPTH):
        shift, scale, gate = ada_modulation(c, mix_ada_w[i], mix_ada_b[i])
        h = rms_norm(x, mix_pre_g[i]) * (1.0 + scale) + shift
        j = i // N_MIXERS
        if i % N_MIXERS == 0:
            y = stick_breaking_mixer(h, sb_w_qkv[j], sb_w_o[j])
        else:
            y = token_mixing_mixer(h, tm_w_in[j], tm_ln_g[j], tm_w_s[j], tm_b_s[j], tm_w_out[j])
        x = x + gate * rms_norm(y, mix_post_g[i])
        shift, scale, gate = ada_modulation(c, ffn_ada_w[i], ffn_ada_b[i])
        h = rms_norm(x, ffn_pre_g[i]) * (1.0 + scale) + shift
        y = swiglu(h, ffn_w_gate[i], ffn_w_up[i], ffn_w_down[i])
        x = x + gate * rms_norm(y, ffn_post_g[i])
    return x
```

```cpp
#include <hip/hip_runtime.h>
#include <hip/hip_cooperative_groups.h>
#include <cstdio>
#include <cstdint>
namespace cg = cooperative_groups;
namespace pg8 {
#define PG8_LAS __attribute__((address_space(3)))
typedef unsigned short bf16_t;
typedef short bf16x8 __attribute__((ext_vector_type(8)));
typedef float f32x4 __attribute__((ext_vector_type(4)));
typedef unsigned u32x4 __attribute__((ext_vector_type(4)));
constexpr int BM = 256, BK = 64, HALF = 128, HTB = HALF * BK * 2  , STAGE_BYTES = 8 * HTB, NXCD = 8, WGM = 8;

__host__ __device__ __forceinline__ int lds_byte(int r, int c) { const int st = (r >> 4) * 2 + (c >> 5), rr = r & 15, cc = c & 31, ob = rr * 64 + cc * 2; return st * 1024 + (ob ^ (((ob >> 9) & 1) << 5)); }
__host__ __device__ __forceinline__ void stage_rc(int b, int& R, int& C) { const int st = b / 1024, sb = b % 1024, swz = sb ^ (((sb >> 9) & 1) << 5); R = (st >> 1) * 16 + swz / 64; C = (st & 1) * 32 + (swz % 64) / 2; }
__host__ __device__ __forceinline__ int perm32(int rho) { const int n = rho >> 4, i = rho & 15; return 8 * (i >> 2) + 4 * n + (i & 3); }

struct Unit { int pm, pn; };
struct Gemm { const bf16_t* A; const bf16_t* Bt; int M, N, K; };

struct StaticOrder {
    int nM, nN, nwg, G, c;
    __host__ __device__ void init(int M, int N, int G_, int c_) { nM = M / BM; nN = N / BM; nwg = nM * nN; G = G_; c = c_; }
    __host__ __device__ bool next(int i, Unit& u) const {
        const long L = (long)i * G + c; if (L >= nwg) return false;
        int wgid = (int)L; { const int q = nwg / NXCD, r = nwg % NXCD, xcd = wgid % NXCD, off = wgid / NXCD; wgid = (xcd < r ? xcd * (q + 1) : r * (q + 1) + (xcd - r) * q) + off; }
        const int nig = WGM * nN, gid = wgid / nig, fm = gid * WGM, gsz = (nM - fm) < WGM ? (nM - fm) : WGM;
        u.pm = fm + ((wgid % nig) % gsz); u.pn = (wgid % nig) / gsz; return true;
    }
    __device__ __forceinline__ void a_ready(const Unit&) const {}
    __device__ __forceinline__ void done(const Unit&) const {}
};

typedef float f32x2_t __attribute__((ext_vector_type(2))); typedef __bf16 bf16x2_t __attribute__((ext_vector_type(2)));
__device__ __forceinline__ unsigned cvtpk(float lo, float hi) { f32x2_t v = {lo, hi}; bf16x2_t b = __builtin_convertvector(v, bf16x2_t); return __builtin_bit_cast(unsigned, b); }
__device__ __forceinline__ float x_sigmoid(float x, float arg) { const float t = __builtin_amdgcn_exp2f(-1.4426950408889634f * arg); return x * __builtin_amdgcn_rcpf(1.0f + t); }
__device__ __forceinline__ float gelu_tanh(float x) { return x_sigmoid(x, 1.5957691216057308f * x * (1.0f + 0.044715f * x * x)); }
__device__ __forceinline__ float silu_f(float x) { return x_sigmoid(x, x); }

template <int ACT> struct EpiAct {
    static constexpr bool PERM = true, AFTER_DRAIN = false;
    bf16_t* O; int ldc; float scale_lo; int scale_cols;
    __device__ __forceinline__ void operator()(const f32x4 (&acc)[2][2][4][2], const Unit& u, int wr, int wc, int fr, int fq) const {
        const int row0 = u.pm * BM + wr * 64 + fr, col0 = u.pn * BM + wc * 32 + 8 * fq;
        const float sc = (u.pn * BM < scale_cols) ? scale_lo : 1.0f;
#pragma unroll
        for (int ai = 0; ai < 2; ++ai)
#pragma unroll
            for (int m = 0; m < 4; ++m) { bf16_t* rowp = O + (size_t)(row0 + ai * HALF + m * 16) * ldc + col0;
#pragma unroll
                for (int bj = 0; bj < 2; ++bj) { f32x4 v0 = acc[ai][bj][m][0], v1 = acc[ai][bj][m][1];
                    if (ACT == 1) {
#pragma unroll
                        for (int j = 0; j < 4; ++j) { v0[j] = gelu_tanh(v0[j]); v1[j] = gelu_tanh(v1[j]); } }
                    v0 = v0 * sc; v1 = v1 * sc; u32x4 w; w.x = cvtpk(v0[0], v0[1]); w.y = cvtpk(v0[2], v0[3]); w.z = cvtpk(v1[0], v1[1]); w.w = cvtpk(v1[2], v1[3]);
                    *(u32x4*)(rowp + bj * HALF) = w; } }
    }
};
struct EpiSwiGLU {
    static constexpr bool PERM = true, AFTER_DRAIN = false;
    bf16_t* O; int ldc;
    __device__ __forceinline__ void operator()(const f32x4 (&acc)[2][2][4][2], const Unit& u, int wr, int wc, int fr, int fq) const {
        const int row0 = u.pm * BM + wr * 64 + fr, col0 = u.pn * HALF + wc * 32 + 8 * fq;
#pragma unroll
        for (int ai = 0; ai < 2; ++ai)
#pragma unroll
            for (int m = 0; m < 4; ++m) { bf16_t* rowp = O + (size_t)(row0 + ai * HALF + m * 16) * ldc + col0;
                f32x4 g0 = acc[ai][0][m][0], g1 = acc[ai][0][m][1]; const f32x4 u0 = acc[ai][1][m][0], u1 = acc[ai][1][m][1];
#pragma unroll
                for (int j = 0; j < 4; ++j) { g0[j] = silu_f(g0[j]) * u0[j]; g1[j] = silu_f(g1[j]) * u1[j]; }
                u32x4 w; w.x = cvtpk(g0[0], g0[1]); w.y = cvtpk(g0[2], g0[3]); w.z = cvtpk(g1[0], g1[1]); w.w = cvtpk(g1[2], g1[3]);
                *(u32x4*)rowp = w; }
    }
};
struct PanelOrder {
    int n, swapped;
    __device__ __forceinline__ bool next(int i, Unit& u) const { if (i >= n) return false; u.pm = swapped ? i : 0; u.pn = swapped ? 0 : i; return true; }
    __device__ __forceinline__ void a_ready(const Unit&) const {}
    __device__ __forceinline__ void done(const Unit&) const {}
};

template <class Epi, class Sched, bool ALIGN_EPI = false, bool SP2 = false>
__device__ __forceinline__ void gemm_phase(PG8_LAS unsigned char* lds, const Gemm g, const Sched& S, const Epi& E) {
    int tid_l = threadIdx.x; asm volatile("" : "+v"(tid_l));
    const int tid = tid_l, wid = __builtin_amdgcn_readfirstlane(tid >> 6), lane = tid & 63, wr = wid >> 2, wc = wid & 3, fr = lane & 15, fq = lane >> 4;
    const int K = g.K, nt = K / BK;
    unsigned voffA[2], voffB[2];
#pragma unroll
    for (int i = 0; i < 2; ++i) { int R, C; stage_rc(tid * 16 + i * 8192, R, C); const int Rb = Epi::PERM ? ((R & ~31) + perm32(R & 31)) : R;
        voffA[i] = (unsigned)(R * K + C) * 2u; voffB[i] = (unsigned)(Rb * K + C) * 2u; }
    const size_t kstep = (size_t)(BK * 2);
    const size_t hstep = (size_t)HALF * K * 2;
    const size_t tstep = 2 * hstep;
    const unsigned ldsw = (unsigned)wid * 1024u;
    const int aoff = lds_byte(wr * 64 + fr, fq * 8), boff = lds_byte(wc * 32 + fr, fq * 8);
#define PG8_SA(b, h) (((b) * 2 + (h)) * HTB)
#define PG8_SB(b, h) ((4 + (b) * 2 + (h)) * HTB)
#define PG8_STAGE(bufoff, gbase, voff) do { _Pragma("unroll") for (int _i = 0; _i < 2; ++_i) \
        __builtin_amdgcn_global_load_lds((const unsigned*)((const char*)(gbase) + (voff)[_i]), (PG8_LAS unsigned*)(lds + (bufoff) + ldsw + _i * 8192), 16, 0, 0); } while (0)
#define PG8_LDA(dst, b, h) do { _Pragma("unroll") for (int m = 0; m < 4; ++m) _Pragma("unroll") for (int k = 0; k < 2; ++k) dst[m][k] = *(const PG8_LAS bf16x8*)(lds + PG8_SA(b, h) + aoff + m * 2048 + k * 1024); } while (0)
#define PG8_LDB(dst, b, h) do { _Pragma("unroll") for (int n = 0; n < 2; ++n) _Pragma("unroll") for (int k = 0; k < 2; ++k) dst[n][k] = *(const PG8_LAS bf16x8*)(lds + PG8_SB(b, h) + boff + n * 2048 + k * 1024); } while (0)
#define PG8_MMA(ai, bj, At, Bt) do { __builtin_amdgcn_s_setprio(1); _Pragma("unroll") for (int m = 0; m < 4; ++m) _Pragma("unroll") for (int n = 0; n < 2; ++n) _Pragma("unroll") for (int k = 0; k < 2; ++k) \
        acc[ai][bj][m][n] = __builtin_amdgcn_mfma_f32_16x16x32_bf16(Bt[n][k], At[m][k], acc[ai][bj][m][n], 0, 0, 0); __builtin_amdgcn_s_setprio(0); } while (0)
#define PG8_WAIT_V(n) asm volatile("s_waitcnt vmcnt(" #n ")" ::: "memory")
#define PG8_WAIT_L(n) asm volatile("s_waitcnt lgkmcnt(" #n ")" ::: "memory")
#define PG8_BAR __builtin_amdgcn_s_barrier()
#define PG8_SCHED __builtin_amdgcn_sched_barrier(0)
    Unit cur, nxt; int ui = 0;
    if (!S.next(0, cur)) return;
    f32x4 acc[2][2][4][2];
#pragma unroll
    for (int a = 0; a < 2; ++a)
#pragma unroll
        for (int b = 0; b < 2; ++b)
#pragma unroll
            for (int m = 0; m < 4; ++m)
#pragma unroll
                for (int n = 0; n < 2; ++n) acc[a][b][m][n] = (f32x4){0.f, 0.f, 0.f, 0.f};
    bf16x8 At[4][2], B0[2][2], B1[2][2];
    const char* cA = (const char*)g.A + (size_t)cur.pm * tstep; const char* cB = (const char*)g.Bt + (size_t)cur.pn * tstep;
    S.a_ready(cur);
    if constexpr (SP2) {
        PG8_STAGE(PG8_SB(0, 0), cB, voffB); PG8_STAGE(PG8_SB(0, 1), cB + hstep, voffB); PG8_STAGE(PG8_SA(0, 0), cA, voffA); PG8_STAGE(PG8_SA(0, 1), cA + hstep, voffA);
        if (wr == 1) PG8_BAR;
        PG8_WAIT_V(2); PG8_BAR;
        PG8_STAGE(PG8_SB(1, 0), cB + kstep, voffB); PG8_STAGE(PG8_SA(1, 0), cA + kstep, voffA); PG8_STAGE(PG8_SB(1, 1), cB + hstep + kstep, voffB);
        PG8_WAIT_V(6); PG8_BAR;
    } else {
        PG8_STAGE(PG8_SB(0, 0), cB, voffB); PG8_STAGE(PG8_SA(0, 0), cA, voffA); PG8_STAGE(PG8_SB(0, 1), cB + hstep, voffB); PG8_STAGE(PG8_SA(0, 1), cA + hstep, voffA);
        if (wr == 1) PG8_BAR;
        PG8_WAIT_V(4); PG8_BAR;
        PG8_STAGE(PG8_SB(1, 0), cB + kstep, voffB); PG8_STAGE(PG8_SA(1, 0), cA + kstep, voffA); PG8_STAGE(PG8_SB(1, 1), cB + hstep + kstep, voffB);
        PG8_WAIT_V(6); PG8_BAR;
    }
    for (;;) {
        const bool has_next = S.next(ui + 1, nxt);
        const char* nA = has_next ? (const char*)g.A + (size_t)nxt.pm * tstep : cA; const char* nB = has_next ? (const char*)g.Bt + (size_t)nxt.pn * tstep : cB;
        for (int t = 0; t < nt; t += 2) {
            const bool last = (t == nt - 2);
            const char* a1 = cA + (size_t)(t + 1) * kstep;
            const char* a2 = last ? nA : cA + (size_t)(t + 2) * kstep; const char* b2 = last ? nB : cB + (size_t)(t + 2) * kstep;
            const char* a3 = a2 + kstep; const char* b3 = b2 + kstep;
            if (last && has_next) S.a_ready(nxt);
            if constexpr (SP2) {
            PG8_LDB(B0, 0, 0); PG8_LDB(B1, 0, 1); PG8_SCHED; PG8_LDA(At, 0, 0); PG8_STAGE(PG8_SA(1, 1), a1 + hstep, voffA);
            PG8_WAIT_V(8); PG8_WAIT_L(0); PG8_BAR; PG8_MMA(0, 0, At, B0); PG8_MMA(0, 1, At, B1); PG8_BAR; PG8_SCHED;
            PG8_LDA(At, 0, 1); PG8_STAGE(PG8_SB(0, 0), b2, voffB); PG8_STAGE(PG8_SB(0, 1), b2 + hstep, voffB); PG8_STAGE(PG8_SA(0, 0), a2, voffA);
            PG8_WAIT_V(8); PG8_WAIT_L(0); PG8_BAR; PG8_MMA(1, 0, At, B0); PG8_MMA(1, 1, At, B1); PG8_BAR; PG8_SCHED;
            PG8_LDB(B0, 1, 0); PG8_LDB(B1, 1, 1); PG8_SCHED; PG8_LDA(At, 1, 0); PG8_STAGE(PG8_SA(0, 1), a2 + hstep, voffA);
            PG8_WAIT_V(8); PG8_WAIT_L(0); PG8_BAR; PG8_MMA(0, 0, At, B0); PG8_MMA(0, 1, At, B1); PG8_BAR; PG8_SCHED;
            PG8_LDA(At, 1, 1); PG8_STAGE(PG8_SB(1, 0), b3, voffB); PG8_STAGE(PG8_SB(1, 1), b3 + hstep, voffB); PG8_STAGE(PG8_SA(1, 0), a3, voffA);
            PG8_WAIT_V(8); PG8_WAIT_L(0); PG8_BAR; PG8_MMA(1, 0, At, B0); PG8_MMA(1, 1, At, B1); PG8_BAR; PG8_SCHED;
            } else {
            PG8_LDB(B0, 0, 0); PG8_SCHED; PG8_LDA(At, 0, 0); PG8_STAGE(PG8_SA(1, 1), a1 + hstep, voffA);
            PG8_WAIT_L(8); PG8_BAR; PG8_WAIT_L(0); PG8_MMA(0, 0, At, B0); PG8_BAR; PG8_SCHED;
            PG8_LDB(B1, 0, 1); PG8_STAGE(PG8_SB(0, 0), b2, voffB);
            PG8_BAR; PG8_WAIT_L(0); PG8_MMA(0, 1, At, B1); PG8_BAR;
            PG8_LDA(At, 0, 1); PG8_STAGE(PG8_SA(0, 0), a2, voffA);
            PG8_BAR; PG8_WAIT_L(0); PG8_MMA(1, 0, At, B0); PG8_BAR; PG8_SCHED;
            PG8_STAGE(PG8_SB(0, 1), b2 + hstep, voffB);
            PG8_WAIT_V(6); PG8_BAR; PG8_MMA(1, 1, At, B1); PG8_BAR;
            PG8_LDB(B0, 1, 0); PG8_SCHED; PG8_LDA(At, 1, 0); PG8_STAGE(PG8_SA(0, 1), a2 + hstep, voffA);
            PG8_WAIT_L(8); PG8_BAR; PG8_WAIT_L(0); PG8_MMA(0, 0, At, B0); PG8_BAR; PG8_SCHED;
            PG8_LDB(B1, 1, 1); PG8_STAGE(PG8_SB(1, 0), b3, voffB);
            PG8_BAR; PG8_WAIT_L(0); PG8_MMA(0, 1, At, B1); PG8_BAR;
            PG8_LDA(At, 1, 1); PG8_STAGE(PG8_SA(1, 0), a3, voffA);
            PG8_BAR; PG8_WAIT_L(0); PG8_MMA(1, 0, At, B0); PG8_BAR; PG8_SCHED;
            PG8_STAGE(PG8_SB(1, 1), b3 + hstep, voffB);
            PG8_WAIT_V(6); PG8_BAR; PG8_MMA(1, 1, At, B1); PG8_BAR;
            }
        }
        if constexpr (ALIGN_EPI) { if (wr == 0) PG8_BAR; }
        if constexpr (!Epi::AFTER_DRAIN) { E(acc, cur, wr, wc, fr, fq); S.done(cur); }
        if (!has_next) break;
#pragma unroll
        for (int a = 0; a < 2; ++a)
#pragma unroll
            for (int b = 0; b < 2; ++b)
#pragma unroll
                for (int m = 0; m < 4; ++m)
#pragma unroll
                    for (int n = 0; n < 2; ++n) acc[a][b][m][n] = (f32x4){0.f, 0.f, 0.f, 0.f};
        cur = nxt; cA = nA; cB = nB; ++ui;
        if constexpr (ALIGN_EPI) { if (wr == 1) PG8_BAR; }
    }
    PG8_WAIT_V(0);
    if constexpr (!ALIGN_EPI) { if (wr == 0) PG8_BAR; }
    PG8_BAR;
    if constexpr (Epi::AFTER_DRAIN) { E.fused(acc, cur, wr, wc, fr, fq, lds, wid, lane); S.done(cur); }
#undef PG8_SA
#undef PG8_SB
#undef PG8_STAGE
#undef PG8_LDA
#undef PG8_LDB
#undef PG8_MMA
#undef PG8_WAIT_V
#undef PG8_WAIT_L
#undef PG8_BAR
#undef PG8_SCHED
}
}

constexpr int NWAVES = 8, NTHREADS = 512;
constexpr int BATCH = 32, SEQ = 2048, D = 1024, M = BATCH * SEQ, NH = 16, FF = 2816, NPANEL = M / 256;
constexpr float EPS = 1e-6f;
constexpr size_t KiB = 1024, MiB = 1024 * 1024;
constexpr size_t WS_WQKV = 0, WS_WO = 6 * MiB, WS_WIN = 8 * MiB, WS_WOUT = 12 * MiB, WS_WGU = 14 * MiB, WGU_BYTES = 11 * MiB, WS_WD = 36 * MiB, WD_BYTES = 5632 * KiB;
constexpr size_t WS_MOD = 47 * MiB;
constexpr size_t WS_QK = 50 * MiB;
constexpr size_t WS_VT = WS_QK + 256 * MiB;
constexpr size_t WS_ARENA = WS_VT + 128 * MiB, ARENA_BYTES = 1920 * KiB, AR_HB = 0, AR_ACT = 512 * KiB;
constexpr size_t WS_END = WS_ARENA + NPANEL * ARENA_BYTES;
constexpr int LDS_BYTES = 147456;

#define LAS __attribute__((address_space(3)))
typedef unsigned short bf16;
typedef unsigned v4u __attribute__((ext_vector_type(4)));
typedef unsigned v2u __attribute__((ext_vector_type(2)));
typedef float f32x4 __attribute__((ext_vector_type(4)));
typedef float f32x16 __attribute__((ext_vector_type(16)));
typedef short bf16x8 __attribute__((ext_vector_type(8)));
#define BSYNC() do { asm volatile("s_waitcnt vmcnt(0) lgkmcnt(0)" ::: "memory"); __syncthreads(); } while (0)
__device__ __forceinline__ float bf_lo(unsigned w) { return __uint_as_float(w << 16); }
__device__ __forceinline__ float bf_hi(unsigned w) { return __uint_as_float(w & 0xffff0000u); }
__device__ __forceinline__ float wave_sum(float v) {
#pragma unroll
    for (int o = 1; o < 64; o <<= 1) v += __shfl_xor(v, o);
    return v;
}

struct Args { const float* in[20]; float* out; unsigned char* ws; int ph_lo, ph_hi; };
enum { I_X = 0, I_C, I_MIX_ADA_W, I_MIX_ADA_B, I_MIX_PRE_G, I_MIX_POST_G, I_SB_WQKV, I_SB_WO, I_TM_WIN, I_TM_LNG, I_TM_WS, I_TM_BS, I_TM_WOUT,
       I_FFN_ADA_W, I_FFN_ADA_B, I_FFN_PRE_G, I_FFN_POST_G, I_FFN_WG, I_FFN_WU, I_FFN_WD };

__device__ __forceinline__ void transpose_item(const float* W, int K, int N, bf16* WT, int k0, int n0, int dst_row0, LAS float* scr, int lane) {
#pragma unroll 8
    for (int i = 0; i < 32; ++i) { const int kk = 2 * i + (lane >> 5); scr[kk * 33 + (lane & 31)] = W[(size_t)(k0 + kk) * N + n0 + (lane & 31)]; }
    asm volatile("s_waitcnt lgkmcnt(0)" ::: "memory");
    const int c = lane & 7;
#pragma unroll
    for (int j = 0; j < 4; ++j) { const int n = (lane >> 3) + 8 * j; const LAS float* s = scr + (8 * c) * 33 + n;
        v4u o; o.x = pg8::cvtpk(s[0 * 33], s[1 * 33]); o.y = pg8::cvtpk(s[2 * 33], s[3 * 33]); o.z = pg8::cvtpk(s[4 * 33], s[5 * 33]); o.w = pg8::cvtpk(s[6 * 33], s[7 * 33]);
        *(v4u*)(WT + (size_t)(dst_row0 + n) * K + k0 + 8 * c) = o; }
    asm volatile("s_waitcnt lgkmcnt(0)" ::: "memory");
}
__device__ __forceinline__ void transpose_mat(const float* W, int K, int N, bf16* WT, int mode, int item, LAS float* scr, int lane) {
    const int nblk = N / 32, kb = item / nblk, nb = item % nblk, n0 = 32 * nb;
    const int dr = (mode == 0) ? n0 : ((n0 >> 7) * 256 + (n0 & 127) + (mode == 2 ? 128 : 0));
    transpose_item(W, K, N, WT, 64 * kb, n0, dr, scr, lane);
}
__device__ __forceinline__ void prologue(const Args& a, LAS unsigned char* lds, int vcu, int G, int wave, int lane, int tid) {
    asm volatile("" : "+v"(lane)); tid = wave * 64 + lane;
    unsigned char* ws = a.ws;
    {
        LAS float* scr = (LAS float*)(lds + wave * 16384);
        const int gw = vcu * NWAVES + wave, NGW = G * NWAVES;
        constexpr int I_QKV = 16 * 96, I_O = 16 * 32, I_IN = 16 * 64, I_OUT = 16 * 32, I_G = 16 * 88, I_DN = 44 * 32;
        constexpr int NITEMS = I_QKV + I_O + I_IN + I_OUT + 4 * I_G + 2 * I_DN;
        for (int it = gw; it < NITEMS; it += NGW) {
            int r = it;
            if (r < I_QKV) { transpose_mat(a.in[I_SB_WQKV], D, 3 * D, (bf16*)(ws + WS_WQKV), 0, r, scr, lane); continue; } r -= I_QKV;
            if (r < I_O) { transpose_mat(a.in[I_SB_WO], D, D, (bf16*)(ws + WS_WO), 0, r, scr, lane); continue; } r -= I_O;
            if (r < I_IN) { transpose_mat(a.in[I_TM_WIN], D, 2 * D, (bf16*)(ws + WS_WIN), 0, r, scr, lane); continue; } r -= I_IN;
            if (r < I_OUT) { transpose_mat(a.in[I_TM_WOUT], D, D, (bf16*)(ws + WS_WOUT), 0, r, scr, lane); continue; } r -= I_OUT;
            if (r < 4 * I_G) { const int l = r / (2 * I_G), q = r % (2 * I_G), up = q / I_G, rr = q % I_G;
                transpose_mat(a.in[up ? I_FFN_WU : I_FFN_WG] + (size_t)l * D * FF, D, FF, (bf16*)(ws + WS_WGU + l * WGU_BYTES), up ? 2 : 1, rr, scr, lane); continue; } r -= 4 * I_G;
            { const int l = r / I_DN, rr = r % I_DN; transpose_mat(a.in[I_FFN_WD] + (size_t)l * FF * D, FF, D, (bf16*)(ws + WS_WD + l * WD_BYTES), 0, rr, scr, lane); }
        }
    }
    BSYNC();
    for (int item = vcu; item < 4 * 48; item += G) {
        const int mi = item / 48, cgp = item % 48, col0 = cgp * 64;
        const float* W = a.in[(mi & 1) ? I_FFN_ADA_W : I_MIX_ADA_W] + (size_t)(mi >> 1) * D * 3 * D;
        const float* bias = a.in[(mi & 1) ? I_FFN_ADA_B : I_MIX_ADA_B] + (size_t)(mi >> 1) * 3 * D;
        LAS float* sc = (LAS float*)(lds + wave * 16384);
        const int k0 = wave * 128;
        for (int idx = lane; idx < 4096; idx += 64) { const int kk = idx & 127, b = idx >> 7; const float cv = a.in[I_C][b * D + k0 + kk]; sc[kk * 32 + b] = pg8::silu_f(cv); }
        asm volatile("s_waitcnt lgkmcnt(0)" ::: "memory");
        float acc[32];
#pragma unroll
        for (int b = 0; b < 32; ++b) acc[b] = 0.f;
        for (int kk = 0; kk < 128; ++kk) {
            const float w = W[(size_t)(k0 + kk) * (3 * D) + col0 + lane];
#pragma unroll
            for (int b4 = 0; b4 < 8; ++b4) { const f32x4 s4 = *(const LAS f32x4*)(sc + kk * 32 + 4 * b4);
                acc[4 * b4 + 0] += s4[0] * w; acc[4 * b4 + 1] += s4[1] * w; acc[4 * b4 + 2] += s4[2] * w; acc[4 * b4 + 3] += s4[3] * w; }
        }
        BSYNC();
        LAS float* red = (LAS float*)lds;
#pragma unroll
        for (int b = 0; b < 32; ++b) red[(wave * 32 + b) * 64 + lane] = acc[b];
        BSYNC();
        float* mod = (float*)(ws + WS_MOD) + (size_t)mi * BATCH * 3 * D;
#pragma unroll
        for (int q = 0; q < 4; ++q) { const int o = tid + NTHREADS * q, b = o >> 6, col = o & 63; float s = bias[col0 + col];
#pragma unroll
            for (int w8 = 0; w8 < 8; ++w8) s += red[(w8 * 32 + b) * 64 + col];
            mod[(size_t)b * 3 * D + col0 + col] = s; }
        BSYNC();
    }
}

template <bool HAS_Y, bool HAS_H>
__device__ __forceinline__ void rowpass(const float* xin, float* xout, const bf16* Y, bf16* H, const float* gate, const float* postg, const float* preg, const float* scale, const float* shift, int wave, int lane) {
    asm volatile("" : "+v"(lane));
    f32x4 a1[4], a2[4], a3[4];
#pragma unroll
    for (int j = 0; j < 4; ++j) { const int c = 256 * j + 4 * lane;
        if (HAS_Y) a1[j] = *(const f32x4*)(gate + c) * *(const f32x4*)(postg + c);
        if (HAS_H) { a2[j] = *(const f32x4*)(preg + c) * (*(const f32x4*)(scale + c) + 1.0f); a3[j] = *(const f32x4*)(shift + c); } }
    for (int row = wave; row < 256; row += NWAVES) {
        f32x4 x[4];
#pragma unroll
        for (int j = 0; j < 4; ++j) x[j] = *(const f32x4*)(xin + (size_t)row * D + 256 * j + 4 * lane);
        if (HAS_Y) {
            f32x4 y[4]; float ss = 0.f;
#pragma unroll
            for (int j = 0; j < 4; ++j) { const v2u w = *(const v2u*)(Y + (size_t)row * D + 256 * j + 4 * lane);
                y[j] = (f32x4){bf_lo(w.x), bf_hi(w.x), bf_lo(w.y), bf_hi(w.y)}; ss += (y[j][0] * y[j][0] + y[j][1] * y[j][1]) + (y[j][2] * y[j][2] + y[j][3] * y[j][3]); }
            const float rs = __builtin_amdgcn_rsqf(wave_sum(ss) * (1.0f / D) + EPS);
#pragma unroll
            for (int j = 0; j < 4; ++j) { x[j] = x[j] + a1[j] * (y[j] * rs); *(f32x4*)(xout + (size_t)row * D + 256 * j + 4 * lane) = x[j]; }
        }
        if (HAS_H) {
            float ss = 0.f;
#pragma unroll
            for (int j = 0; j < 4; ++j) ss += (x[j][0] * x[j][0] + x[j][1] * x[j][1]) + (x[j][2] * x[j][2] + x[j][3] * x[j][3]);
            const float rs = __builtin_amdgcn_rsqf(wave_sum(ss) * (1.0f / D) + EPS);
#pragma unroll
            for (int j = 0; j < 4; ++j) { const f32x4 h = (x[j] * rs) * a2[j] + a3[j]; v2u w; w.x = pg8::cvtpk(h[0], h[1]); w.y = pg8::cvtpk(h[2], h[3]);
                *(v2u*)(H + (size_t)row * D + 256 * j + 4 * lane) = w; }
        }
    }
}

__device__ __forceinline__ void attn_panel(const bf16* QK, const bf16* VT, bf16* O, int panel, int wave, int lane) {
    asm volatile("" : "+v"(lane));
    const int r = lane & 31, h = lane >> 5;
    const int tok0 = panel * 256 + wave * 32, pos0 = (panel & 7) * 256 + wave * 32, seq0 = (panel >> 3) * SEQ;
    const int pr = 16 * ((r >> 2) & 1) + (r & 3) + 4 * (r >> 3);
    for (int head = 0; head < NH; ++head) {
        bf16x8 qf[4];
        { const bf16* qp = QK + (size_t)(tok0 + r) * 2048 + head * 64 + 8 * h;
#pragma unroll
          for (int d0 = 0; d0 < 4; ++d0) qf[d0] = *(const bf16x8*)(qp + 16 * d0); }
        f32x16 o0, o1;
#pragma unroll
        for (int i = 0; i < 16; ++i) { o0[i] = 0.f; o1[i] = 0.f; }
        float C = 1.0f;
        const int kdiag = pos0 >> 5;
        for (int kt = kdiag; kt >= 0; --kt) {
            const int key0 = kt * 32;
            bf16x8 kf[4], vf[2][2];
            { const bf16* kp = QK + (size_t)(seq0 + key0 + pr) * 2048 + 1024 + head * 64 + 8 * h;
#pragma unroll
              for (int d0 = 0; d0 < 4; ++d0) kf[d0] = *(const bf16x8*)(kp + 16 * d0); }
#pragma unroll
            for (int db = 0; db < 2; ++db)
#pragma unroll
                for (int s = 0; s < 2; ++s) vf[db][s] = *(const bf16x8*)(VT + (size_t)(head * 64 + db * 32 + r) * M + seq0 + key0 + 16 * h + 8 * s);
            f32x16 sc;
#pragma unroll
            for (int i = 0; i < 16; ++i) sc[i] = 0.f;
#pragma unroll
            for (int d0 = 0; d0 < 4; ++d0) sc = __builtin_amdgcn_mfma_f32_32x32x16_bf16(kf[d0], qf[d0], sc, 0, 0, 0);
            float om[16], be[16];
            const bool diag = (kt == kdiag);
#pragma unroll
            for (int i = 0; i < 16; ++i) {
                const float e = __builtin_amdgcn_exp2f(fminf(sc[i], 100.0f));
                float o1m = __builtin_amdgcn_rcpf(1.0f + e), b = e * o1m;
                if (diag && (16 * h + i >= r)) { o1m = 1.0f; b = 0.0f; }
                om[i] = o1m; be[i] = b;
            }
            float L[16]; L[15] = 1.0f;
#pragma unroll
            for (int i = 14; i >= 0; --i) L[i] = L[i + 1] * om[i + 1];
            const float T = L[0] * om[0], Tp = __shfl_xor(T, 32);
            const float t1 = h ? T : Tp, t0 = h ? Tp : T;
            const float Cmid = C * t1, Cin = h ? C : Cmid;
            C = Cmid * t0;
            float av[16];
#pragma unroll
            for (int i = 0; i < 16; ++i) av[i] = be[i] * (L[i] * Cin);
            bf16x8 pa[2];
#pragma unroll
            for (int s = 0; s < 2; ++s) { v4u p; p.x = pg8::cvtpk(av[8 * s], av[8 * s + 1]); p.y = pg8::cvtpk(av[8 * s + 2], av[8 * s + 3]); p.z = pg8::cvtpk(av[8 * s + 4], av[8 * s + 5]); p.w = pg8::cvtpk(av[8 * s + 6], av[8 * s + 7]);
                pa[s] = __builtin_bit_cast(bf16x8, p); }
#pragma unroll
            for (int s = 0; s < 2; ++s) { o0 = __builtin_amdgcn_mfma_f32_32x32x16_bf16(pa[s], vf[0][s], o0, 0, 0, 0); o1 = __builtin_amdgcn_mfma_f32_32x32x16_bf16(pa[s], vf[1][s], o1, 0, 0, 0); }
            if (!__any(C >= 1e-37f)) break;
        }
#pragma unroll
        for (int i = 0; i < 16; ++i) { const int q = (i & 3) + 8 * (i >> 2) + 4 * h; bf16* op = O + (size_t)(wave * 32 + q) * D + head * 64 + r;
            op[0] = (bf16)(pg8::cvtpk(o0[i], 0.f) & 0xffffu); op[32] = (bf16)(pg8::cvtpk(o1[i], 0.f) & 0xffffu); }
    }
}

__device__ __forceinline__ void tokmix_panel(const bf16* U, const bf16* GVT, bf16* Ymix, const float* Ws, const float* bs, const float* lng, LAS unsigned char* lds, int wave, int lane, int tid) {
    asm volatile("" : "+v"(lane)); tid = wave * 64 + lane;
    LAS float* part = (LAS float*)lds;
    LAS float* mu = part + 4096; LAS float* rstd = mu + 256; LAS float* rt = rstd + 256 + wave * 32;
    {
        float s[4] = {0.f, 0.f, 0.f, 0.f}, ss[4] = {0.f, 0.f, 0.f, 0.f};
        const bf16* gp = GVT + (size_t)(wave * 128) * 256 + 4 * lane;
#pragma unroll 8
        for (int ch = 0; ch < 128; ++ch) { const v2u w = *(const v2u*)(gp + (size_t)ch * 256); const float v0 = bf_lo(w.x), v1 = bf_hi(w.x), v2 = bf_lo(w.y), v3 = bf_hi(w.y);
            s[0] += v0; s[1] += v1; s[2] += v2; s[3] += v3; ss[0] += v0 * v0; ss[1] += v1 * v1; ss[2] += v2 * v2; ss[3] += v3 * v3; }
#pragma unroll
        for (int k = 0; k < 4; ++k) { part[(wave * 256 + 4 * lane + k) * 2] = s[k]; part[(wave * 256 + 4 * lane + k) * 2 + 1] = ss[k]; }
    }
    BSYNC();
    if (tid < 256) { float s = 0.f, ss = 0.f;
#pragma unroll
        for (int w = 0; w < 8; ++w) { s += part[(w * 256 + tid) * 2]; ss += part[(w * 256 + tid) * 2 + 1]; }
        const float mean = s * (1.0f / D), var = fmaxf(ss * (1.0f / D) - mean * mean, 0.f);
        mu[tid] = mean; rstd[tid] = __builtin_amdgcn_rsqf(var + EPS); }
    BSYNC();
    const int r = lane & 31, h = lane >> 5, tb = wave & 3, cb0 = (wave >> 2) * 2;
    const int nks = (tb < 2) ? 4 : 8;
    for (int n = 0; n < 2; ++n)
        for (int g = 0; g < 8; ++g) {
            f32x16 acc0, acc1;
#pragma unroll
            for (int i = 0; i < 16; ++i) { acc0[i] = 0.f; acc1[i] = 0.f; }
            float rp = 0.f;
            const float* wrow = Ws + ((size_t)g * 128 + tb * 32 + r) * 128;
            const bf16* b0p = GVT + (size_t)(g * 128 + cb0 * 32 + r) * 256 + n * 128;
            for (int ks = 0; ks < nks; ++ks) {
                const int s0 = 16 * ks + 8 * h;
                const f32x4 w0 = *(const f32x4*)(wrow + s0), w1 = *(const f32x4*)(wrow + s0 + 4);
                const f32x4 r0 = *(const LAS f32x4*)(rstd + n * 128 + s0), r1 = *(const LAS f32x4*)(rstd + n * 128 + s0 + 4);
                const f32x4 m0 = *(const LAS f32x4*)(mu + n * 128 + s0), m1 = *(const LAS f32x4*)(mu + n * 128 + s0 + 4);
                v4u p; p.x = pg8::cvtpk(w0[0] * r0[0], w0[1] * r0[1]); p.y = pg8::cvtpk(w0[2] * r0[2], w0[3] * r0[3]); p.z = pg8::cvtpk(w1[0] * r1[0], w1[1] * r1[1]); p.w = pg8::cvtpk(w1[2] * r1[2], w1[3] * r1[3]);
                rp += (bf_lo(p.x) * m0[0] + bf_hi(p.x) * m0[1]) + (bf_lo(p.y) * m0[2] + bf_hi(p.y) * m0[3]) + (bf_lo(p.z) * m1[0] + bf_hi(p.z) * m1[1]) + (bf_lo(p.w) * m1[2] + bf_hi(p.w) * m1[3]);
                const bf16x8 af = __builtin_bit_cast(bf16x8, p);
                const bf16x8 bf0 = *(const bf16x8*)(b0p + s0), bf1 = *(const bf16x8*)(b0p + 32 * 256 + s0);
                acc0 = __builtin_amdgcn_mfma_f32_32x32x16_bf16(af, bf0, acc0, 0, 0, 0);
                acc1 = __builtin_amdgcn_mfma_f32_32x32x16_bf16(af, bf1, acc1, 0, 0, 0);
            }
            rp += __shfl_xor(rp, 32);
            asm volatile("s_waitcnt lgkmcnt(0)" ::: "memory");
            if (h == 0) rt[r] = rp;
            asm volatile("s_waitcnt lgkmcnt(0)" ::: "memory");
            const int c0 = g * 128 + cb0 * 32 + r;
            const float g0 = lng[c0], g1 = lng[c0 + 32];
#pragma unroll
            for (int i = 0; i < 16; ++i) { const int t = (i & 3) + 8 * (i >> 2) + 4 * h; const float rv = rt[t], bsv = bs[g * 128 + tb * 32 + t];
                const size_t off = (size_t)(n * 128 + tb * 32 + t) * D + c0;
                const float u0 = bf_lo((unsigned)U[off]), u1 = bf_lo((unsigned)U[off + 32]);
                const float y0 = u0 * (g0 * (acc0[i] - rv) + bsv), y1 = u1 * (g1 * (acc1[i] - rv) + bsv);
                Ymix[off] = (bf16)(pg8::cvtpk(y0, 0.f) & 0xffffu); Ymix[off + 32] = (bf16)(pg8::cvtpk(y1, 0.f) & 0xffffu); }
            asm volatile("s_waitcnt lgkmcnt(0)" ::: "memory");
        }
}

template <class Epi> __device__ __forceinline__ void run_gemm(LAS unsigned char* lds, const bf16* A, const bf16* Bt, int K, int nunits, int swapped, const Epi& E) {
    pg8::Gemm g{A, Bt, 0, 0, K}; pg8::PanelOrder S{nunits, swapped};
    pg8::gemm_phase<Epi, pg8::PanelOrder, true, true>(lds, g, S, E);
}

__global__ void __launch_bounds__(NTHREADS, 2) fwd_kernel(Args a) {
    extern __shared__ __attribute__((aligned(16))) unsigned char lds_raw[];
    LAS unsigned char* lds = (LAS unsigned char*)lds_raw;
    const int tid = threadIdx.x, lane = tid & 63, wave = __builtin_amdgcn_readfirstlane(tid >> 6);
    const int G = gridDim.x, bx = blockIdx.x, vcu = (G % 8 == 0) ? (bx % 8) * (G / 8) + bx / 8 : bx;
    unsigned char* ws = a.ws;
    const int lo = a.ph_lo, hi = a.ph_hi;
    const float* mod = (const float*)(ws + WS_MOD);
#define MODP(mi, b, part) (mod + ((size_t)(mi) * BATCH + (b)) * 3 * D + (part) * D)

    if (lo <= 0 && 0 < hi) prologue(a, lds, vcu, G, wave, lane, tid);
    if (lo <= 0 && 1 < hi) cg::this_grid().sync();

    if (lo <= 1 && 1 < hi) {
        for (int panel = vcu; panel < NPANEL; panel += G) {
            const int b = panel >> 3; unsigned char* ar = ws + WS_ARENA + (size_t)panel * ARENA_BYTES;
            bf16* HB = (bf16*)(ar + AR_HB);
            rowpass<false, true>(a.in[I_X] + (size_t)panel * 256 * D, nullptr, nullptr, HB, nullptr, nullptr, a.in[I_MIX_PRE_G], MODP(0, b, 1), MODP(0, b, 0), wave, lane);
            BSYNC();
            { pg8::EpiAct<0> E{(bf16*)(ws + WS_QK) + (size_t)panel * 256 * 2048, 2048, 0.125f * 1.4426950408889634f, 1024};
              run_gemm(lds, HB, (const bf16*)(ws + WS_WQKV), D, 8, 0, E); }
            { pg8::EpiAct<0> E{(bf16*)(ws + WS_VT) + (size_t)panel * 256, M, 1.0f, 0};
              run_gemm(lds, (const bf16*)(ws + WS_WQKV) + (size_t)2048 * D, HB, D, 4, 1, E); }
        }
    }
    if (lo <= 1 && 2 < hi) cg::this_grid().sync();

    if (lo <= 2 && 2 < hi) {
        for (int panel = vcu; panel < NPANEL; panel += G) {
            const int b = panel >> 3; unsigned char* ar = ws + WS_ARENA + (size_t)panel * ARENA_BYTES;
            bf16* HB = (bf16*)(ar + AR_HB); bf16* ACT = (bf16*)(ar + AR_ACT); bf16* GVT = (bf16*)(ar + AR_ACT + 512 * KiB);
            const float* xin = a.in[I_X] + (size_t)panel * 256 * D; float* xo = a.out + (size_t)panel * 256 * D;
            attn_panel((const bf16*)(ws + WS_QK), (const bf16*)(ws + WS_VT), HB, panel, wave, lane);
            BSYNC();
            { pg8::EpiAct<0> E{ACT, D, 1.0f, 0}; run_gemm(lds, HB, (const bf16*)(ws + WS_WO), D, 4, 0, E); }
            rowpass<true, true>(xin, xo, ACT, HB, MODP(0, b, 2), a.in[I_MIX_POST_G], a.in[I_FFN_PRE_G], MODP(1, b, 1), MODP(1, b, 0), wave, lane);
            BSYNC();
            { pg8::EpiSwiGLU E{ACT, FF}; run_gemm(lds, HB, (const bf16*)(ws + WS_WGU), D, 22, 0, E); }
            { pg8::EpiAct<0> E{HB, D, 1.0f, 0}; run_gemm(lds, ACT, (const bf16*)(ws + WS_WD), FF, 4, 0, E); }
            rowpass<true, true>(xo, xo, HB, HB, MODP(1, b, 2), a.in[I_FFN_POST_G], a.in[I_MIX_PRE_G] + D, MODP(2, b, 1), MODP(2, b, 0), wave, lane);
            BSYNC();
            { pg8::EpiAct<1> E{ACT, D, 1.0f, 0}; run_gemm(lds, HB, (const bf16*)(ws + WS_WIN), D, 4, 0, E); }
            { pg8::EpiAct<1> E{GVT, 256, 1.0f, 0}; run_gemm(lds, (const bf16*)(ws + WS_WIN) + (size_t)D * D, HB, D, 4, 1, E); }
            tokmix_panel(ACT, GVT, HB, a.in[I_TM_WS], a.in[I_TM_BS], a.in[I_TM_LNG], lds, wave, lane, tid);
            BSYNC();
            { pg8::EpiAct<0> E{ACT, D, 1.0f, 0}; run_gemm(lds, HB, (const bf16*)(ws + WS_WOUT), D, 4, 0, E); }
            rowpass<true, true>(xo, xo, ACT, HB, MODP(2, b, 2), a.in[I_MIX_POST_G] + D, a.in[I_FFN_PRE_G] + D, MODP(3, b, 1), MODP(3, b, 0), wave, lane);
            BSYNC();
            { pg8::EpiSwiGLU E{ACT, FF}; run_gemm(lds, HB, (const bf16*)(ws + WS_WGU + WGU_BYTES), D, 22, 0, E); }
            { pg8::EpiAct<0> E{HB, D, 1.0f, 0}; run_gemm(lds, ACT, (const bf16*)(ws + WS_WD + WD_BYTES), FF, 4, 0, E); }
            rowpass<true, false>(xo, xo, HB, nullptr, MODP(3, b, 2), a.in[I_FFN_POST_G] + D, nullptr, nullptr, nullptr, wave, lane);
            BSYNC();
        }
    }
#undef MODP
}

#ifndef MK_N_LAUNCHES
#define MK_N_LAUNCHES 1
#endif
extern "C" void kernel_launch(void* const* d_in, const int* in_sizes, int n_in, void* d_out, int out_size, void* d_ws, size_t ws_size, hipStream_t stream) {
    static int grid = 0;
    if (grid == 0) {
        if (n_in != 20 || in_sizes[0] != M * D || out_size != M * D || ws_size < WS_END) { fprintf(stderr, "kernel_launch: unexpected shapes (n_in %d, in0 %d, out %d, ws %zu < %zu)\n", n_in, n_in > 0 ? in_sizes[0] : -1, out_size, ws_size, (size_t)WS_END); grid = -1; return; }
        int dev = 0, cus = 0, per_cu = 0;
        if (hipGetDevice(&dev) != hipSuccess || hipDeviceGetAttribute(&cus, hipDeviceAttributeMultiprocessorCount, dev) != hipSuccess) { grid = -1; return; }
        if (hipFuncSetAttribute((const void*)fwd_kernel, hipFuncAttributeMaxDynamicSharedMemorySize, LDS_BYTES) != hipSuccess) { fprintf(stderr, "kernel_launch: hipFuncSetAttribute failed\n"); grid = -1; return; }
        if (hipOccupancyMaxActiveBlocksPerMultiprocessor(&per_cu, (const void*)fwd_kernel, NTHREADS, LDS_BYTES) != hipSuccess || per_cu < 1) { fprintf(stderr, "kernel_launch: occupancy query says %d\n", per_cu); per_cu = 1; }
        (void)hipGetLastError();
        grid = cus * 1;
        if (grid > NPANEL) grid = NPANEL;
    }
    if (grid < 0) return;
    Args a{};
    for (int i = 0; i < 20; ++i) a.in[i] = (const float*)d_in[i];
    a.out = (float*)d_out; a.ws = (unsigned char*)d_ws;
#if MK_N_LAUNCHES == 1
    a.ph_lo = 0; a.ph_hi = 3;
    void* args[] = {&a};
    hipError_t e = hipLaunchCooperativeKernel((const void*)fwd_kernel, dim3(grid), dim3(NTHREADS), args, LDS_BYTES, stream);
    if (e != hipSuccess) fprintf(stderr, "kernel_launch: cooperative launch failed: %s (grid %d)\n", hipGetErrorString(e), grid);
#else
    for (int li = 0; li < 3; ++li) { a.ph_lo = li; a.ph_hi = li + 1; hipLaunchKernelGGL(fwd_kernel, dim3(grid), dim3(NTHREADS), LDS_BYTES, stream, a); }
#endif
}
```

```cpp
#include <hip/hip_runtime.h>
#include <hip/hip_cooperative_groups.h>
#include <cstdio>
#include <cstdint>
namespace cg = cooperative_groups;
namespace pg8 {
#define PG8_LAS __attribute__((address_space(3)))
typedef unsigned short bf16_t;
typedef short bf16x8 __attribute__((ext_vector_type(8)));
typedef float f32x4 __attribute__((ext_vector_type(4)));
typedef unsigned u32x4 __attribute__((ext_vector_type(4)));
constexpr int BM = 256, BK = 64, HALF = 128, HTB = HALF * BK * 2  , STAGE_BYTES = 8 * HTB, NXCD = 8, WGM = 8;

__host__ __device__ __forceinline__ int lds_byte(int r, int c) { const int st = (r >> 4) * 2 + (c >> 5), rr = r & 15, cc = c & 31, ob = rr * 64 + cc * 2; return st * 1024 + (ob ^ (((ob >> 9) & 1) << 5)); }
__host__ __device__ __forceinline__ void stage_rc(int b, int& R, int& C) { const int st = b / 1024, sb = b % 1024, swz = sb ^ (((sb >> 9) & 1) << 5); R = (st >> 1) * 16 + swz / 64; C = (st & 1) * 32 + (swz % 64) / 2; }
__host__ __device__ __forceinline__ int perm32(int rho) { const int n = rho >> 4, i = rho & 15; return 8 * (i >> 2) + 4 * n + (i & 3); }

struct Unit { int pm, pn; };
struct Gemm { const bf16_t* A; const bf16_t* Bt; int M, N, K; };

struct StaticOrder {
    int nM, nN, nwg, G, c;
    __host__ __device__ void init(int M, int N, int G_, int c_) { nM = M / BM; nN = N / BM; nwg = nM * nN; G = G_; c = c_; }
    __host__ __device__ bool next(int i, Unit& u) const {
        const long L = (long)i * G + c; if (L >= nwg) return false;
        int wgid = (int)L; { const int q = nwg / NXCD, r = nwg % NXCD, xcd = wgid % NXCD, off = wgid / NXCD; wgid = (xcd < r ? xcd * (q + 1) : r * (q + 1) + (xcd - r) * q) + off; }
        const int nig = WGM * nN, gid = wgid / nig, fm = gid * WGM, gsz = (nM - fm) < WGM ? (nM - fm) : WGM;
        u.pm = fm + ((wgid % nig) % gsz); u.pn = (wgid % nig) / gsz; return true;
    }
    __device__ __forceinline__ void a_ready(const Unit&) const {}
    __device__ __forceinline__ void done(const Unit&) const {}
};

typedef float f32x2_t __attribute__((ext_vector_type(2))); typedef __bf16 bf16x2_t __attribute__((ext_vector_type(2)));
__device__ __forceinline__ unsigned cvtpk(float lo, float hi) { f32x2_t v = {lo, hi}; bf16x2_t b = __builtin_convertvector(v, bf16x2_t); return __builtin_bit_cast(unsigned, b); }
__device__ __forceinline__ float x_sigmoid(float x, float arg) { const float t = __builtin_amdgcn_exp2f(-1.4426950408889634f * arg); return x * __builtin_amdgcn_rcpf(1.0f + t); }
__device__ __forceinline__ float gelu_tanh(float x) { return x_sigmoid(x, 1.5957691216057308f * x * (1.0f + 0.044715f * x * x)); }
__device__ __forceinline__ float silu_f(float x) { return x_sigmoid(x, x); }

template <int ACT> struct EpiAct {
    static constexpr bool PERM = true, AFTER_DRAIN = false;
    bf16_t* O; int ldc; float scale_lo; int scale_cols;
    __device__ __forceinline__ void operator()(const f32x4 (&acc)[2][2][4][2], const Unit& u, int wr, int wc, int fr, int fq) const {
        const int row0 = u.pm * BM + wr * 64 + fr, col0 = u.pn * BM + wc * 32 + 8 * fq;
        const float sc = (u.pn * BM < scale_cols) ? scale_lo : 1.0f;
#pragma unroll
        for (int ai = 0; ai < 2; ++ai)
#pragma unroll
            for (int m = 0; m < 4; ++m) { bf16_t* rowp = O + (size_t)(row0 + ai * HALF + m * 16) * ldc + col0;
#pragma unroll
                for (int bj = 0; bj < 2; ++bj) { f32x4 v0 = acc[ai][bj][m][0], v1 = acc[ai][bj][m][1];
                    if (ACT == 1) {
#pragma unroll
                        for (int j = 0; j < 4; ++j) { v0[j] = gelu_tanh(v0[j]); v1[j] = gelu_tanh(v1[j]); } }
                    v0 = v0 * sc; v1 = v1 * sc; u32x4 w; w.x = cvtpk(v0[0], v0[1]); w.y = cvtpk(v0[2], v0[3]); w.z = cvtpk(v1[0], v1[1]); w.w = cvtpk(v1[2], v1[3]);
                    *(u32x4*)(rowp + bj * HALF) = w; } }
    }
};
struct EpiSwiGLU {
    static constexpr bool PERM = true, AFTER_DRAIN = false;
    bf16_t* O; int ldc;
    __device__ __forceinline__ void operator()(const f32x4 (&acc)[2][2][4][2], const Unit& u, int wr, int wc, int fr, int fq) const {
        const int row0 = u.pm * BM + wr * 64 + fr, col0 = u.pn * HALF + wc * 32 + 8 * fq;
#pragma unroll
        for (int ai = 0; ai < 2; ++ai)
#pragma unroll
            for (int m = 0; m < 4; ++m) { bf16_t* rowp = O + (size_t)(row0 + ai * HALF + m * 16) * ldc + col0;
                f32x4 g0 = acc[ai][0][m][0], g1 = acc[ai][0][m][1]; const f32x4 u0 = acc[ai][1][m][0], u1 = acc[ai][1][m][1];
#pragma unroll
                for (int j = 0; j < 4; ++j) { g0[j] = silu_f(g0[j]) * u0[j]; g1[j] = silu_f(g1[j]) * u1[j]; }
                u32x4 w; w.x = cvtpk(g0[0], g0[1]); w.y = cvtpk(g0[2], g0[3]); w.z = cvtpk(g1[0], g1[1]); w.w = cvtpk(g1[2], g1[3]);
                *(u32x4*)rowp = w; }
    }
};
struct PanelOrder {
    int n, swapped;
    __device__ __forceinline__ bool next(int i, Unit& u) const { if (i >= n) return false; u.pm = swapped ? i : 0; u.pn = swapped ? 0 : i; return true; }
    __device__ __forceinline__ void a_ready(const Unit&) const {}
    __device__ __forceinline__ void done(const Unit&) const {}
};

template <class Epi, class Sched, bool ALIGN_EPI = false, bool SP2 = false>
__device__ __forceinline__ void gemm_phase(PG8_LAS unsigned char* lds, const Gemm g, const Sched& S, const Epi& E) {
    int tid_l = threadIdx.x; asm volatile("" : "+v"(tid_l));
    const int tid = tid_l, wid = __builtin_amdgcn_readfirstlane(tid >> 6), lane = tid & 63, wr = wid >> 2, wc = wid & 3, fr = lane & 15, fq = lane >> 4;
    const int K = g.K, nt = K / BK;
    unsigned voffA[2], voffB[2];
#pragma unroll
    for (int i = 0; i < 2; ++i) { int R, C; stage_rc(tid * 16 + i * 8192, R, C); const int Rb = Epi::PERM ? ((R & ~31) + perm32(R & 31)) : R;
        voffA[i] = (unsigned)(R * K + C) * 2u; voffB[i] = (unsigned)(Rb * K + C) * 2u; }
    const size_t kstep = (size_t)(BK * 2);
    const size_t hstep = (size_t)HALF * K * 2;
    const size_t tstep = 2 * hstep;
    const unsigned ldsw = (unsigned)wid * 1024u;
    const int aoff = lds_byte(wr * 64 + fr, fq * 8), boff = lds_byte(wc * 32 + fr, fq * 8);
#define PG8_SA(b, h) (((b) * 2 + (h)) * HTB)
#define PG8_SB(b, h) ((4 + (b) * 2 + (h)) * HTB)
#define PG8_STAGE(bufoff, gbase, voff) do { _Pragma("unroll") for (int _i = 0; _i < 2; ++_i) \
        __builtin_amdgcn_global_load_lds((const unsigned*)((const char*)(gbase) + (voff)[_i]), (PG8_LAS unsigned*)(lds + (bufoff) + ldsw + _i * 8192), 16, 0, 0); } while (0)
#define PG8_LDA(dst, b, h) do { _Pragma("unroll") for (int m = 0; m < 4; ++m) _Pragma("unroll") for (int k = 0; k < 2; ++k) dst[m][k] = *(const PG8_LAS bf16x8*)(lds + PG8_SA(b, h) + aoff + m * 2048 + k * 1024); } while (0)
#define PG8_LDB(dst, b, h) do { _Pragma("unroll") for (int n = 0; n < 2; ++n) _Pragma("unroll") for (int k = 0; k < 2; ++k) dst[n][k] = *(const PG8_LAS bf16x8*)(lds + PG8_SB(b, h) + boff + n * 2048 + k * 1024); } while (0)
#define PG8_MMA(ai, bj, At, Bt) do { __builtin_amdgcn_s_setprio(1); _Pragma("unroll") for (int m = 0; m < 4; ++m) _Pragma("unroll") for (int n = 0; n < 2; ++n) _Pragma("unroll") for (int k = 0; k < 2; ++k) \
        acc[ai][bj][m][n] = __builtin_amdgcn_mfma_f32_16x16x32_bf16(Bt[n][k], At[m][k], acc[ai][bj][m][n], 0, 0, 0); __builtin_amdgcn_s_setprio(0); } while (0)
#define PG8_WAIT_V(n) asm volatile("s_waitcnt vmcnt(" #n ")" ::: "memory")
#define PG8_WAIT_L(n) asm volatile("s_waitcnt lgkmcnt(" #n ")" ::: "memory")
#define PG8_BAR __builtin_amdgcn_s_barrier()
#define PG8_SCHED __builtin_amdgcn_sched_barrier(0)
    Unit cur, nxt; int ui = 0;
    if (!S.next(0, cur)) return;
    f32x4 acc[2][2][4][2];
#pragma unroll
    for (int a = 0; a < 2; ++a)
#pragma unroll
        for (int b = 0; b < 2; ++b)
#pragma unroll
            for (int m = 0; m < 4; ++m)
#pragma unroll
                for (int n = 0; n < 2; ++n) acc[a][b][m][n] = (f32x4){0.f, 0.f, 0.f, 0.f};
    bf16x8 At[4][2], B0[2][2], B1[2][2];
    const char* cA = (const char*)g.A + (size_t)cur.pm * tstep; const char* cB = (const char*)g.Bt + (size_t)cur.pn * tstep;
    S.a_ready(cur);
    if constexpr (SP2) {
        PG8_STAGE(PG8_SB(0, 0), cB, voffB); PG8_STAGE(PG8_SB(0, 1), cB + hstep, voffB); PG8_STAGE(PG8_SA(0, 0), cA, voffA); PG8_STAGE(PG8_SA(0, 1), cA + hstep, voffA);
        if (wr == 1) PG8_BAR;
        PG8_WAIT_V(2); PG8_BAR;
        PG8_STAGE(PG8_SB(1, 0), cB + kstep, voffB); PG8_STAGE(PG8_SA(1, 0), cA + kstep, voffA); PG8_STAGE(PG8_SB(1, 1), cB + hstep + kstep, voffB);
        PG8_WAIT_V(6); PG8_BAR;
    } else {
        PG8_STAGE(PG8_SB(0, 0), cB, voffB); PG8_STAGE(PG8_SA(0, 0), cA, voffA); PG8_STAGE(PG8_SB(0, 1), cB + hstep, voffB); PG8_STAGE(PG8_SA(0, 1), cA + hstep, voffA);
        if (wr == 1) PG8_BAR;
        PG8_WAIT_V(4); PG8_BAR;
        PG8_STAGE(PG8_SB(1, 0), cB + kstep, voffB); PG8_STAGE(PG8_SA(1, 0), cA + kstep, voffA); PG8_STAGE(PG8_SB(1, 1), cB + hstep + kstep, voffB);
        PG8_WAIT_V(6); PG8_BAR;
    }
    for (;;) {
        const bool has_next = S.next(ui + 1, nxt);
        const char* nA = has_next ? (const char*)g.A + (size_t)nxt.pm * tstep : cA; const char* nB = has_next ? (const char*)g.Bt + (size_t)nxt.pn * tstep : cB;
        for (int t = 0; t < nt; t += 2) {
            const bool last = (t == nt - 2);
            const char* a1 = cA + (size_t)(t + 1) * kstep;
            const char* a2 = last ? nA : cA + (size_t)(t + 2) * kstep; const char* b2 = last ? nB : cB + (size_t)(t + 2) * kstep;
            const char* a3 = a2 + kstep; const char* b3 = b2 + kstep;
            if (last && has_next) S.a_ready(nxt);
            if constexpr (SP2) {
            PG8_LDB(B0, 0, 0); PG8_LDB(B1, 0, 1); PG8_SCHED; PG8_LDA(At, 0, 0); PG8_STAGE(PG8_SA(1, 1), a1 + hstep, voffA);
            PG8_WAIT_V(8); PG8_WAIT_L(0); PG8_BAR; PG8_MMA(0, 0, At, B0); PG8_MMA(0, 1, At, B1); PG8_BAR; PG8_SCHED;
            PG8_LDA(At, 0, 1); PG8_STAGE(PG8_SB(0, 0), b2, voffB); PG8_STAGE(PG8_SB(0, 1), b2 + hstep, voffB); PG8_STAGE(PG8_SA(0, 0), a2, voffA);
            PG8_WAIT_V(8); PG8_WAIT_L(0); PG8_BAR; PG8_MMA(1, 0, At, B0); PG8_MMA(1, 1, At, B1); PG8_BAR; PG8_SCHED;
            PG8_LDB(B0, 1, 0); PG8_LDB(B1, 1, 1); PG8_SCHED; PG8_LDA(At, 1, 0); PG8_STAGE(PG8_SA(0, 1), a2 + hstep, voffA);
            PG8_WAIT_V(8); PG8_WAIT_L(0); PG8_BAR; PG8_MMA(0, 0, At, B0); PG8_MMA(0, 1, At, B1); PG8_BAR; PG8_SCHED;
            PG8_LDA(At, 1, 1); PG8_STAGE(PG8_SB(1, 0), b3, voffB); PG8_STAGE(PG8_SB(1, 1), b3 + hstep, voffB); PG8_STAGE(PG8_SA(1, 0), a3, voffA);
            PG8_WAIT_V(8); PG8_WAIT_L(0); PG8_BAR; PG8_MMA(1, 0, At, B0); PG8_MMA(1, 1, At, B1); PG8_BAR; PG8_SCHED;
            } else {
            PG8_LDB(B0, 0, 0); PG8_SCHED; PG8_LDA(At, 0, 0); PG8_STAGE(PG8_SA(1, 1), a1 + hstep, voffA);
            PG8_WAIT_L(8); PG8_BAR; PG8_WAIT_L(0); PG8_MMA(0, 0, At, B0); PG8_BAR; PG8_SCHED;
            PG8_LDB(B1, 0, 1); PG8_STAGE(PG8_SB(0, 0), b2, voffB);
            PG8_BAR; PG8_WAIT_L(0); PG8_MMA(0, 1, At, B1); PG8_BAR;
            PG8_LDA(At, 0, 1); PG8_STAGE(PG8_SA(0, 0), a2, voffA);
            PG8_BAR; PG8_WAIT_L(0); PG8_MMA(1, 0, At, B0); PG8_BAR; PG8_SCHED;
            PG8_STAGE(PG8_SB(0, 1), b2 + hstep, voffB);
            PG8_WAIT_V(6); PG8_BAR; PG8_MMA(1, 1, At, B1); PG8_BAR;
            PG8_LDB(B0, 1, 0); PG8_SCHED; PG8_LDA(At, 1, 0); PG8_STAGE(PG8_SA(0, 1), a2 + hstep, voffA);
            PG8_WAIT_L(8); PG8_BAR; PG8_WAIT_L(0); PG8_MMA(0, 0, At, B0); PG8_BAR; PG8_SCHED;
            PG8_LDB(B1, 1, 1); PG8_STAGE(PG8_SB(1, 0), b3, voffB);
            PG8_BAR; PG8_WAIT_L(0); PG8_MMA(0, 1, At, B1); PG8_BAR;
            PG8_LDA(At, 1, 1); PG8_STAGE(PG8_SA(1, 0), a3, voffA);
            PG8_BAR; PG8_WAIT_L(0); PG8_MMA(1, 0, At, B0); PG8_BAR; PG8_SCHED;
            PG8_STAGE(PG8_SB(1, 1), b3 + hstep, voffB);
            PG8_WAIT_V(6); PG8_BAR; PG8_MMA(1, 1, At, B1); PG8_BAR;
            }
        }
        if constexpr (ALIGN_EPI) { if (wr == 0) PG8_BAR; }
        if constexpr (!Epi::AFTER_DRAIN) { E(acc, cur, wr, wc, fr, fq); S.done(cur); }
        if (!has_next) break;
#pragma unroll
        for (int a = 0; a < 2; ++a)
#pragma unroll
            for (int b = 0; b < 2; ++b)
#pragma unroll
                for (int m = 0; m < 4; ++m)
#pragma unroll
                    for (int n = 0; n < 2; ++n) acc[a][b][m][n] = (f32x4){0.f, 0.f, 0.f, 0.f};
        cur = nxt; cA = nA; cB = nB; ++ui;
        if constexpr (ALIGN_EPI) { if (wr == 1) PG8_BAR; }
    }
    PG8_WAIT_V(0);
    if constexpr (!ALIGN_EPI) { if (wr == 0) PG8_BAR; }
    PG8_BAR;
    if constexpr (Epi::AFTER_DRAIN) { E.fused(acc, cur, wr, wc, fr, fq, lds, wid, lane); S.done(cur); }
#undef PG8_SA
#undef PG8_SB
#undef PG8_STAGE
#undef PG8_LDA
#undef PG8_LDB
#undef PG8_MMA
#undef PG8_WAIT_V
#undef PG8_WAIT_L
#undef PG8_BAR
#undef PG8_SCHED
}
}

#ifndef REP_ATTN
#define REP_ATTN 1
#endif
#ifndef REP_RP1
#define REP_RP1 1
#endif
#ifndef REP_TOK
#define REP_TOK 1
#endif
constexpr int NWAVES = 8, NTHREADS = 512;
constexpr int BATCH = 32, SEQ = 2048, D = 1024, M = BATCH * SEQ, NH = 16, FF = 2816, NPANEL = M / 256;
constexpr float EPS = 1e-6f;
constexpr size_t KiB = 1024, MiB = 1024 * 1024;
constexpr size_t WS_WQKV = 0, WS_WO = 6 * MiB, WS_WIN = 8 * MiB, WS_WOUT = 12 * MiB, WS_WGU = 14 * MiB, WGU_BYTES = 11 * MiB, WS_WD = 36 * MiB, WD_BYTES = 5632 * KiB;
constexpr size_t WS_MOD = 47 * MiB;
constexpr size_t WS_QK = 50 * MiB;
constexpr size_t WS_VT = WS_QK + 256 * MiB;
constexpr size_t WS_ARENA = WS_VT + 128 * MiB, ARENA_BYTES = 1920 * KiB, AR_HB = 0, AR_ACT = 512 * KiB;
constexpr size_t WS_END = WS_ARENA + NPANEL * ARENA_BYTES;
constexpr int LDS_BYTES = 147456;

#define LAS __attribute__((address_space(3)))
typedef unsigned short bf16;
typedef unsigned v4u __attribute__((ext_vector_type(4)));
typedef unsigned v2u __attribute__((ext_vector_type(2)));
typedef float f32x4 __attribute__((ext_vector_type(4)));
typedef float f32x16 __attribute__((ext_vector_type(16)));
typedef short bf16x8 __attribute__((ext_vector_type(8)));
#define BSYNC() do { asm volatile("s_waitcnt vmcnt(0) lgkmcnt(0)" ::: "memory"); __syncthreads(); } while (0)
__device__ __forceinline__ float bf_lo(unsigned w) { return __uint_as_float(w << 16); }
__device__ __forceinline__ float bf_hi(unsigned w) { return __uint_as_float(w & 0xffff0000u); }
__device__ __forceinline__ float wave_sum(float v) {
#pragma unroll
    for (int o = 1; o < 64; o <<= 1) v += __shfl_xor(v, o);
    return v;
}

struct Args { const float* in[20]; float* out; unsigned char* ws; int ph_lo, ph_hi; };
enum { I_X = 0, I_C, I_MIX_ADA_W, I_MIX_ADA_B, I_MIX_PRE_G, I_MIX_POST_G, I_SB_WQKV, I_SB_WO, I_TM_WIN, I_TM_LNG, I_TM_WS, I_TM_BS, I_TM_WOUT,
       I_FFN_ADA_W, I_FFN_ADA_B, I_FFN_PRE_G, I_FFN_POST_G, I_FFN_WG, I_FFN_WU, I_FFN_WD };

__device__ __forceinline__ void transpose_item(const float* W, int K, int N, bf16* WT, int k0, int n0, int dst_row0, LAS float* scr, int lane) {
#pragma unroll 8
    for (int i = 0; i < 32; ++i) { const int kk = 2 * i + (lane >> 5); scr[kk * 33 + (lane & 31)] = W[(size_t)(k0 + kk) * N + n0 + (lane & 31)]; }
    asm volatile("s_waitcnt lgkmcnt(0)" ::: "memory");
    const int c = lane & 7;
#pragma unroll
    for (int j = 0; j < 4; ++j) { const int n = (lane >> 3) + 8 * j; const LAS float* s = scr + (8 * c) * 33 + n;
        v4u o; o.x = pg8::cvtpk(s[0 * 33], s[1 * 33]); o.y = pg8::cvtpk(s[2 * 33], s[3 * 33]); o.z = pg8::cvtpk(s[4 * 33], s[5 * 33]); o.w = pg8::cvtpk(s[6 * 33], s[7 * 33]);
        *(v4u*)(WT + (size_t)(dst_row0 + n) * K + k0 + 8 * c) = o; }
    asm volatile("s_waitcnt lgkmcnt(0)" ::: "memory");
}
__device__ __forceinline__ void transpose_mat(const float* W, int K, int N, bf16* WT, int mode, int item, LAS float* scr, int lane) {
    const int nblk = N / 32, kb = item / nblk, nb = item % nblk, n0 = 32 * nb;
    const int dr = (mode == 0) ? n0 : ((n0 >> 7) * 256 + (n0 & 127) + (mode == 2 ? 128 : 0));
    transpose_item(W, K, N, WT, 64 * kb, n0, dr, scr, lane);
}
__device__ __forceinline__ void prologue(const Args& a, LAS unsigned char* lds, int vcu, int G, int wave, int lane, int tid) {
    asm volatile("" : "+v"(lane)); tid = wave * 64 + lane;
    unsigned char* ws = a.ws;
    {
        LAS float* scr = (LAS float*)(lds + wave * 16384);
        const int gw = vcu * NWAVES + wave, NGW = G * NWAVES;
        constexpr int I_QKV = 16 * 96, I_O = 16 * 32, I_IN = 16 * 64, I_OUT = 16 * 32, I_G = 16 * 88, I_DN = 44 * 32;
        constexpr int NITEMS = I_QKV + I_O + I_IN + I_OUT + 4 * I_G + 2 * I_DN;
        for (int it = gw; it < NITEMS; it += NGW) {
            int r = it;
            if (r < I_QKV) { transpose_mat(a.in[I_SB_WQKV], D, 3 * D, (bf16*)(ws + WS_WQKV), 0, r, scr, lane); continue; } r -= I_QKV;
            if (r < I_O) { transpose_mat(a.in[I_SB_WO], D, D, (bf16*)(ws + WS_WO), 0, r, scr, lane); continue; } r -= I_O;
            if (r < I_IN) { transpose_mat(a.in[I_TM_WIN], D, 2 * D, (bf16*)(ws + WS_WIN), 0, r, scr, lane); continue; } r -= I_IN;
            if (r < I_OUT) { transpose_mat(a.in[I_TM_WOUT], D, D, (bf16*)(ws + WS_WOUT), 0, r, scr, lane); continue; } r -= I_OUT;
            if (r < 4 * I_G) { const int l = r / (2 * I_G), q = r % (2 * I_G), up = q / I_G, rr = q % I_G;
                transpose_mat(a.in[up ? I_FFN_WU : I_FFN_WG] + (size_t)l * D * FF, D, FF, (bf16*)(ws + WS_WGU + l * WGU_BYTES), up ? 2 : 1, rr, scr, lane); continue; } r -= 4 * I_G;
            { const int l = r / I_DN, rr = r % I_DN; transpose_mat(a.in[I_FFN_WD] + (size_t)l * FF * D, FF, D, (bf16*)(ws + WS_WD + l * WD_BYTES), 0, rr, scr, lane); }
        }
    }
    BSYNC();
    for (int item = vcu; item < 4 * 48; item += G) {
        const int mi = item / 48, cgp = item % 48, col0 = cgp * 64;
        const float* W = a.in[(mi & 1) ? I_FFN_ADA_W : I_MIX_ADA_W] + (size_t)(mi >> 1) * D * 3 * D;
        const float* bias = a.in[(mi & 1) ? I_FFN_ADA_B : I_MIX_ADA_B] + (size_t)(mi >> 1) * 3 * D;
        LAS float* sc = (LAS float*)(lds + wave * 16384);
        const int k0 = wave * 128;
        for (int idx = lane; idx < 4096; idx += 64) { const int kk = idx & 127, b = idx >> 7; const float cv = a.in[I_C][b * D + k0 + kk]; sc[kk * 32 + b] = pg8::silu_f(cv); }
        asm volatile("s_waitcnt lgkmcnt(0)" ::: "memory");
        float acc[32];
#pragma unroll
        for (int b = 0; b < 32; ++b) acc[b] = 0.f;
        for (int kk = 0; kk < 128; ++kk) {
            const float w = W[(size_t)(k0 + kk) * (3 * D) + col0 + lane];
#pragma unroll
            for (int b4 = 0; b4 < 8; ++b4) { const f32x4 s4 = *(const LAS f32x4*)(sc + kk * 32 + 4 * b4);
                acc[4 * b4 + 0] += s4[0] * w; acc[4 * b4 + 1] += s4[1] * w; acc[4 * b4 + 2] += s4[2] * w; acc[4 * b4 + 3] += s4[3] * w; }
        }
        BSYNC();
        LAS float* red = (LAS float*)lds;
#pragma unroll
        for (int b = 0; b < 32; ++b) red[(wave * 32 + b) * 64 + lane] = acc[b];
        BSYNC();
        float* mod = (float*)(ws + WS_MOD) + (size_t)mi * BATCH * 3 * D;
#pragma unroll
        for (int q = 0; q < 4; ++q) { const int o = tid + NTHREADS * q, b = o >> 6, col = o & 63; float s = bias[col0 + col];
#pragma unroll
            for (int w8 = 0; w8 < 8; ++w8) s += red[(w8 * 32 + b) * 64 + col];
            mod[(size_t)b * 3 * D + col0 + col] = s; }
        BSYNC();
    }
}

template <bool HAS_Y, bool HAS_H>
__device__ __forceinline__ void rowpass(const float* xin, float* xout, const bf16* Y, bf16* H, const float* gate, const float* postg, const float* preg, const float* scale, const float* shift, int wave, int lane) {
    asm volatile("" : "+v"(lane));
    f32x4 a1[4], a2[4], a3[4];
#pragma unroll
    for (int j = 0; j < 4; ++j) { const int c = 256 * j + 4 * lane;
        if (HAS_Y) a1[j] = *(const f32x4*)(gate + c) * *(const f32x4*)(postg + c);
        if (HAS_H) { a2[j] = *(const f32x4*)(preg + c) * (*(const f32x4*)(scale + c) + 1.0f); a3[j] = *(const f32x4*)(shift + c); } }
    for (int row = wave; row < 256; row += NWAVES) {
        f32x4 x[4];
#pragma unroll
        for (int j = 0; j < 4; ++j) x[j] = *(const f32x4*)(xin + (size_t)row * D + 256 * j + 4 * lane);
        if (HAS_Y) {
            f32x4 y[4]; float ss = 0.f;
#pragma unroll
            for (int j = 0; j < 4; ++j) { const v2u w = *(const v2u*)(Y + (size_t)row * D + 256 * j + 4 * lane);
                y[j] = (f32x4){bf_lo(w.x), bf_hi(w.x), bf_lo(w.y), bf_hi(w.y)}; ss += (y[j][0] * y[j][0] + y[j][1] * y[j][1]) + (y[j][2] * y[j][2] + y[j][3] * y[j][3]); }
            const float rs = __builtin_amdgcn_rsqf(wave_sum(ss) * (1.0f / D) + EPS);
#pragma unroll
            for (int j = 0; j < 4; ++j) { x[j] = x[j] + a1[j] * (y[j] * rs); *(f32x4*)(xout + (size_t)row * D + 256 * j + 4 * lane) = x[j]; }
        }
        if (HAS_H) {
            float ss = 0.f;
#pragma unroll
            for (int j = 0; j < 4; ++j) ss += (x[j][0] * x[j][0] + x[j][1] * x[j][1]) + (x[j][2] * x[j][2] + x[j][3] * x[j][3]);
            const float rs = __builtin_amdgcn_rsqf(wave_sum(ss) * (1.0f / D) + EPS);
#pragma unroll
            for (int j = 0; j < 4; ++j) { const f32x4 h = (x[j] * rs) * a2[j] + a3[j]; v2u w; w.x = pg8::cvtpk(h[0], h[1]); w.y = pg8::cvtpk(h[2], h[3]);
                *(v2u*)(H + (size_t)row * D + 256 * j + 4 * lane) = w; }
        }
    }
}

__device__ __forceinline__ void attn_panel(const bf16* QK, const bf16* VT, bf16* O, LAS unsigned char* lds, int panel, int wave, int lane) {
    asm volatile("" : "+v"(lane));
    const int r = lane & 31, h = lane >> 5;
    const int tok0 = panel * 256 + wave * 32, pos0 = (panel & 7) * 256 + wave * 32, seq0 = (panel >> 3) * SEQ;
    const int pr = 16 * ((r >> 2) & 1) + (r & 3) + 4 * (r >> 3);
    LAS bf16* stg = (LAS bf16*)lds + wave * (32 * 72);
    const int row = lane >> 1, half = lane & 1;
#define LOADKV(KF, VF, KT) do { const int Tk_ = seq0 + (KT) * 32; \
        const bf16* kp_ = QK + (size_t)(Tk_ + pr) * 2048 + 1024 + head * 64 + 8 * h; \
        const bf16* vp_ = VT + (size_t)(Tk_ >> 8) * (1024 * 256) + (size_t)(head * 64 + r) * 256 + (Tk_ & 255) + 16 * h; \
        _Pragma("unroll") for (int d0 = 0; d0 < 4; ++d0) KF[d0] = *(const bf16x8*)(kp_ + 16 * d0); \
        _Pragma("unroll") for (int db = 0; db < 2; ++db) _Pragma("unroll") for (int s = 0; s < 2; ++s) VF[db][s] = *(const bf16x8*)(vp_ + db * 32 * 256 + 8 * s); } while (0)
    for (int head = 0; head < NH; ++head) {
        bf16x8 qf[4];
        { const bf16* qp = QK + (size_t)(tok0 + r) * 2048 + head * 64 + 8 * h;
#pragma unroll
          for (int d0 = 0; d0 < 4; ++d0) qf[d0] = *(const bf16x8*)(qp + 16 * d0); }
        f32x16 o0, o1;
#pragma unroll
        for (int i = 0; i < 16; ++i) { o0[i] = 0.f; o1[i] = 0.f; }
        float C = 1.0f;
        const int kdiag = pos0 >> 5;
        bf16x8 kf[4], vf[2][2], kfn[4], vfn[2][2];
        LOADKV(kf, vf, kdiag);
        for (int kt = kdiag;;) {
            const int ktn = kt > 0 ? kt - 1 : 0;
            LOADKV(kfn, vfn, ktn);
            f32x16 sc;
#pragma unroll
            for (int i = 0; i < 16; ++i) sc[i] = 0.f;
#pragma unroll
            for (int d0 = 0; d0 < 4; ++d0) sc = __builtin_amdgcn_mfma_f32_32x32x16_bf16(kf[d0], qf[d0], sc, 0, 0, 0);
            float om[16], be[16];
            const bool diag = (kt == kdiag);
#pragma unroll
            for (int i = 0; i < 16; ++i) {
                const float e = __builtin_amdgcn_exp2f(fminf(sc[i], 100.0f));
                float o1m = __builtin_amdgcn_rcpf(1.0f + e), b = e * o1m;
                if (diag && (16 * h + i >= r)) { o1m = 1.0f; b = 0.0f; }
                om[i] = o1m; be[i] = b;
            }
            float L[16]; L[15] = 1.0f;
#pragma unroll
            for (int i = 14; i >= 0; --i) L[i] = L[i + 1] * om[i + 1];
            const float T = L[0] * om[0], Tp = __shfl_xor(T, 32);
            const float t1 = h ? T : Tp, t0 = h ? Tp : T;
            const float Cmid = C * t1, Cin = h ? C : Cmid;
            C = Cmid * t0;
            float av[16];
#pragma unroll
            for (int i = 0; i < 16; ++i) av[i] = be[i] * (L[i] * Cin);
            bf16x8 pa[2];
#pragma unroll
            for (int s = 0; s < 2; ++s) { v4u p; p.x = pg8::cvtpk(av[8 * s], av[8 * s + 1]); p.y = pg8::cvtpk(av[8 * s + 2], av[8 * s + 3]); p.z = pg8::cvtpk(av[8 * s + 4], av[8 * s + 5]); p.w = pg8::cvtpk(av[8 * s + 6], av[8 * s + 7]);
                pa[s] = __builtin_bit_cast(bf16x8, p); }
#pragma unroll
            for (int s = 0; s < 2; ++s) { o0 = __builtin_amdgcn_mfma_f32_32x32x16_bf16(pa[s], vf[0][s], o0, 0, 0, 0); o1 = __builtin_amdgcn_mfma_f32_32x32x16_bf16(pa[s], vf[1][s], o1, 0, 0, 0); }
            if (kt == 0 || !__any(C >= 1e-37f)) break;
#pragma unroll
            for (int d0 = 0; d0 < 4; ++d0) kf[d0] = kfn[d0];
#pragma unroll
            for (int db = 0; db < 2; ++db)
#pragma unroll
                for (int s = 0; s < 2; ++s) vf[db][s] = vfn[db][s];
            --kt;
        }
        asm volatile("s_waitcnt lgkmcnt(0)" ::: "memory");
#pragma unroll
        for (int i = 0; i < 16; ++i) { const int q = (i & 3) + 8 * (i >> 2) + 4 * h;
            stg[q * 72 + r] = (bf16)(pg8::cvtpk(o0[i], 0.f) & 0xffffu); stg[q * 72 + 32 + r] = (bf16)(pg8::cvtpk(o1[i], 0.f) & 0xffffu); }
        asm volatile("s_waitcnt lgkmcnt(0)" ::: "memory");
        { bf16* op = O + (size_t)(wave * 32 + row) * D + head * 64 + half * 32;
#pragma unroll
          for (int k = 0; k < 4; ++k) { const v4u v = *(const LAS v4u*)(stg + row * 72 + half * 32 + 8 * k); *(v4u*)(op + 8 * k) = v; } }
        asm volatile("s_waitcnt lgkmcnt(0)" ::: "memory");
    }
#undef LOADKV
}

__device__ __forceinline__ void tokmix_panel(const bf16* U, const bf16* GVT, bf16* Ymix, const float* Ws, const float* bs, const float* lng, LAS unsigned char* lds, int wave, int lane, int tid) {
    asm volatile("" : "+v"(lane)); tid = wave * 64 + lane;
    LAS float* part = (LAS float*)lds;
    LAS float* mu = part + 4096; LAS float* rstd = mu + 256; LAS float* rt = rstd + 256 + wave * 32;
    LAS float* stg = (LAS float*)(lds + 32768) + wave * (32 * 68);
    LAS float* lg = (LAS float*)(lds + 102400); LAS float* lb = lg + 1024;
    {
        float s[4] = {0.f, 0.f, 0.f, 0.f}, ss[4] = {0.f, 0.f, 0.f, 0.f};
        const bf16* gp = GVT + (size_t)(wave * 128) * 256 + 4 * lane;
#pragma unroll 16
        for (int ch = 0; ch < 128; ++ch) { const v2u w = *(const v2u*)(gp + (size_t)ch * 256); const float v0 = bf_lo(w.x), v1 = bf_hi(w.x), v2 = bf_lo(w.y), v3 = bf_hi(w.y);
            s[0] += v0; s[1] += v1; s[2] += v2; s[3] += v3; ss[0] += v0 * v0; ss[1] += v1 * v1; ss[2] += v2 * v2; ss[3] += v3 * v3; }
#pragma unroll
        for (int k = 0; k < 4; ++k) { part[(wave * 256 + 4 * lane + k) * 2] = s[k]; part[(wave * 256 + 4 * lane + k) * 2 + 1] = ss[k]; }
        lg[tid] = lng[tid]; lg[tid + 512] = lng[tid + 512]; lb[tid] = bs[tid]; lb[tid + 512] = bs[tid + 512];
    }
    BSYNC();
    if (tid < 256) { float s = 0.f, ss = 0.f;
#pragma unroll
        for (int w = 0; w < 8; ++w) { s += part[(w * 256 + tid) * 2]; ss += part[(w * 256 + tid) * 2 + 1]; }
        const float mean = s * (1.0f / D), var = fmaxf(ss * (1.0f / D) - mean * mean, 0.f);
        mu[tid] = mean; rstd[tid] = __builtin_amdgcn_rsqf(var + EPS); }
    BSYNC();
    const int r = lane & 31, h = lane >> 5, tb = wave & 3, cb0 = (wave >> 2) * 2;
    const float khi = (tb < 2) ? 0.f : 1.f;
    const int row = lane >> 1, half = lane & 1;
    f32x4 wa[8][2]; bf16x8 b0[8], b1[8]; v4u uu[4];
#define LOADFR(NG) do { const int n_ = (NG) >> 3, g_ = (NG) & 7; \
        const float* wrow_ = Ws + ((size_t)g_ * 128 + tb * 32 + r) * 128 + 8 * h; \
        const bf16* b0p_ = GVT + (size_t)(g_ * 128 + cb0 * 32 + r) * 256 + n_ * 128 + 8 * h; \
        const bf16* up_ = U + (size_t)(n_ * 128 + tb * 32 + row) * D + g_ * 128 + cb0 * 32 + half * 32; \
        _Pragma("unroll") for (int ks = 0; ks < 8; ++ks) { wa[ks][0] = *(const f32x4*)(wrow_ + 16 * ks); wa[ks][1] = *(const f32x4*)(wrow_ + 16 * ks + 4); \
            b0[ks] = *(const bf16x8*)(b0p_ + 16 * ks); b1[ks] = *(const bf16x8*)(b0p_ + 32 * 256 + 16 * ks); } \
        _Pragma("unroll") for (int q = 0; q < 4; ++q) uu[q] = *(const v4u*)(up_ + 8 * q); } while (0)
    LOADFR(0);
    for (int ng = 0; ng < 16; ++ng) {
        const int n = ng >> 3, g = ng & 7;
        f32x16 acc0, acc1;
#pragma unroll
        for (int i = 0; i < 16; ++i) { acc0[i] = 0.f; acc1[i] = 0.f; }
        float rp = 0.f;
#pragma unroll
        for (int ks = 0; ks < 8; ++ks) {
            const int s0 = n * 128 + 16 * ks + 8 * h;
            f32x4 r0 = *(const LAS f32x4*)(rstd + s0), r1 = *(const LAS f32x4*)(rstd + s0 + 4);
            const f32x4 m0 = *(const LAS f32x4*)(mu + s0), m1 = *(const LAS f32x4*)(mu + s0 + 4);
            if (ks >= 4) { r0 = r0 * khi; r1 = r1 * khi; }
            const f32x4 w0 = wa[ks][0] * r0, w1 = wa[ks][1] * r1;
            v4u p; p.x = pg8::cvtpk(w0[0], w0[1]); p.y = pg8::cvtpk(w0[2], w0[3]); p.z = pg8::cvtpk(w1[0], w1[1]); p.w = pg8::cvtpk(w1[2], w1[3]);
            rp += (bf_lo(p.x) * m0[0] + bf_hi(p.x) * m0[1]) + (bf_lo(p.y) * m0[2] + bf_hi(p.y) * m0[3]) + (bf_lo(p.z) * m1[0] + bf_hi(p.z) * m1[1]) + (bf_lo(p.w) * m1[2] + bf_hi(p.w) * m1[3]);
            const bf16x8 af = __builtin_bit_cast(bf16x8, p);
            acc0 = __builtin_amdgcn_mfma_f32_32x32x16_bf16(af, b0[ks], acc0, 0, 0, 0);
            acc1 = __builtin_amdgcn_mfma_f32_32x32x16_bf16(af, b1[ks], acc1, 0, 0, 0);
        }
        v4u uc[4];
#pragma unroll
        for (int q = 0; q < 4; ++q) uc[q] = uu[q];
        if (ng + 1 < 16) LOADFR(ng + 1);
        rp += __shfl_xor(rp, 32);
        asm volatile("s_waitcnt lgkmcnt(0)" ::: "memory");
        if (h == 0) rt[r] = rp;
#pragma unroll
        for (int i = 0; i < 16; ++i) { const int t = (i & 3) + 8 * (i >> 2) + 4 * h; stg[t * 68 + r] = acc0[i]; stg[t * 68 + 32 + r] = acc1[i]; }
        asm volatile("s_waitcnt lgkmcnt(0)" ::: "memory");
        const float rv = rt[row], bsv = lb[g * 128 + tb * 32 + row];
        const LAS float* gp = lg + g * 128 + cb0 * 32 + half * 32;
        bf16* yp = Ymix + (size_t)(n * 128 + tb * 32 + row) * D + g * 128 + cb0 * 32 + half * 32;
#pragma unroll
        for (int q = 0; q < 4; ++q) {
            const f32x4 s0v = *(const LAS f32x4*)(stg + row * 68 + half * 32 + 8 * q), s1v = *(const LAS f32x4*)(stg + row * 68 + half * 32 + 8 * q + 4);
            const f32x4 g0 = *(const LAS f32x4*)(gp + 8 * q), g1 = *(const LAS f32x4*)(gp + 8 * q + 4);
            const f32x4 u0 = (f32x4){bf_lo(uc[q].x), bf_hi(uc[q].x), bf_lo(uc[q].y), bf_hi(uc[q].y)}, u1 = (f32x4){bf_lo(uc[q].z), bf_hi(uc[q].z), bf_lo(uc[q].w), bf_hi(uc[q].w)};
            const f32x4 y0 = u0 * (g0 * (s0v - rv) + bsv), y1 = u1 * (g1 * (s1v - rv) + bsv);
            v4u o; o.x = pg8::cvtpk(y0[0], y0[1]); o.y = pg8::cvtpk(y0[2], y0[3]); o.z = pg8::cvtpk(y1[0], y1[1]); o.w = pg8::cvtpk(y1[2], y1[3]);
            *(v4u*)(yp + 8 * q) = o;
        }
        asm volatile("s_waitcnt lgkmcnt(0)" ::: "memory");
    }
#undef LOADFR
}

template <class Epi> __device__ __forceinline__ void run_gemm(LAS unsigned char* lds, const bf16* A, const bf16* Bt, int K, int nunits, int swapped, const Epi& E) {
    pg8::Gemm g{A, Bt, 0, 0, K}; pg8::PanelOrder S{nunits, swapped};
    pg8::gemm_phase<Epi, pg8::PanelOrder, true, true>(lds, g, S, E);
}

__global__ void __launch_bounds__(NTHREADS, 2) fwd_kernel(Args a) {
    extern __shared__ __attribute__((aligned(16))) unsigned char lds_raw[];
    LAS unsigned char* lds = (LAS unsigned char*)lds_raw;
    const int tid = threadIdx.x, lane = tid & 63, wave = __builtin_amdgcn_readfirstlane(tid >> 6);
    const int G = gridDim.x, bx = blockIdx.x, vcu = (G % 8 == 0) ? (bx % 8) * (G / 8) + bx / 8 : bx;
    unsigned char* ws = a.ws;
    const int lo = a.ph_lo, hi = a.ph_hi;
    const float* mod = (const float*)(ws + WS_MOD);
#define MODP(mi, b, part) (mod + ((size_t)(mi) * BATCH + (b)) * 3 * D + (part) * D)

    if (lo <= 0 && 0 < hi) prologue(a, lds, vcu, G, wave, lane, tid);
    if (lo <= 0 && 1 < hi) cg::this_grid().sync();

    if (lo <= 1 && 1 < hi) {
        for (int panel = vcu; panel < NPANEL; panel += G) {
            const int b = panel >> 3; unsigned char* ar = ws + WS_ARENA + (size_t)panel * ARENA_BYTES;
            bf16* HB = (bf16*)(ar + AR_HB);
            rowpass<false, true>(a.in[I_X] + (size_t)panel * 256 * D, nullptr, nullptr, HB, nullptr, nullptr, a.in[I_MIX_PRE_G], MODP(0, b, 1), MODP(0, b, 0), wave, lane);
            BSYNC();
            { pg8::EpiAct<0> E{(bf16*)(ws + WS_QK) + (size_t)panel * 256 * 2048, 2048, 0.125f * 1.4426950408889634f, 1024};
              run_gemm(lds, HB, (const bf16*)(ws + WS_WQKV), D, 8, 0, E); }
            { pg8::EpiAct<0> E{(bf16*)(ws + WS_VT) + (size_t)panel * (1024 * 256), 256, 1.0f, 0};
              run_gemm(lds, (const bf16*)(ws + WS_WQKV) + (size_t)2048 * D, HB, D, 4, 1, E); }
        }
    }
    if (lo <= 1 && 2 < hi) cg::this_grid().sync();

    if (lo <= 2 && 2 < hi) {
        for (int panel = vcu; panel < NPANEL; panel += G) {
            const int b = panel >> 3; unsigned char* ar = ws + WS_ARENA + (size_t)panel * ARENA_BYTES;
            bf16* HB = (bf16*)(ar + AR_HB); bf16* ACT = (bf16*)(ar + AR_ACT); bf16* GVT = (bf16*)(ar + AR_ACT + 512 * KiB);
            const float* xin = a.in[I_X] + (size_t)panel * 256 * D; float* xo = a.out + (size_t)panel * 256 * D;
            for (int rep = 0; rep < REP_ATTN; ++rep) { attn_panel((const bf16*)(ws + WS_QK), (const bf16*)(ws + WS_VT), HB, lds, panel, wave, lane);
            BSYNC(); }
            { pg8::EpiAct<0> E{ACT, D, 1.0f, 0}; run_gemm(lds, HB, (const bf16*)(ws + WS_WO), D, 4, 0, E); }
            for (int rep = 0; rep < REP_RP1; ++rep) { rowpass<true, true>(xin, xo, ACT, HB, MODP(0, b, 2), a.in[I_MIX_POST_G], a.in[I_FFN_PRE_G], MODP(1, b, 1), MODP(1, b, 0), wave, lane);
            BSYNC(); }
            { pg8::EpiSwiGLU E{ACT, FF}; run_gemm(lds, HB, (const bf16*)(ws + WS_WGU), D, 22, 0, E); }
            { pg8::EpiAct<0> E{HB, D, 1.0f, 0}; run_gemm(lds, ACT, (const bf16*)(ws + WS_WD), FF, 4, 0, E); }
            rowpass<true, true>(xo, xo, HB, HB, MODP(1, b, 2), a.in[I_FFN_POST_G], a.in[I_MIX_PRE_G] + D, MODP(2, b, 1), MODP(2, b, 0), wave, lane);
            BSYNC();
            { pg8::EpiAct<1> E{ACT, D, 1.0f, 0}; run_gemm(lds, HB, (const bf16*)(ws + WS_WIN), D, 4, 0, E); }
            { pg8::EpiAct<1> E{GVT, 256, 1.0f, 0}; run_gemm(lds, (const bf16*)(ws + WS_WIN) + (size_t)D * D, HB, D, 4, 1, E); }
            for (int rep = 0; rep < REP_TOK; ++rep) { tokmix_panel(ACT, GVT, HB, a.in[I_TM_WS], a.in[I_TM_BS], a.in[I_TM_LNG], lds, wave, lane, tid);
            BSYNC(); }
            { pg8::EpiAct<0> E{ACT, D, 1.0f, 0}; run_gemm(lds, HB, (const bf16*)(ws + WS_WOUT), D, 4, 0, E); }
            rowpass<true, true>(xo, xo, ACT, HB, MODP(2, b, 2), a.in[I_MIX_POST_G] + D, a.in[I_FFN_PRE_G] + D, MODP(3, b, 1), MODP(3, b, 0), wave, lane);
            BSYNC();
            { pg8::EpiSwiGLU E{ACT, FF}; run_gemm(lds, HB, (const bf16*)(ws + WS_WGU + WGU_BYTES), D, 22, 0, E); }
            { pg8::EpiAct<0> E{HB, D, 1.0f, 0}; run_gemm(lds, ACT, (const bf16*)(ws + WS_WD + WD_BYTES), FF, 4, 0, E); }
            rowpass<true, false>(xo, xo, HB, nullptr, MODP(3, b, 2), a.in[I_FFN_POST_G] + D, nullptr, nullptr, nullptr, wave, lane);
            BSYNC();
        }
    }
#undef MODP
}

#ifndef MK_N_LAUNCHES
#define MK_N_LAUNCHES 1
#endif
extern "C" void kernel_launch(void* const* d_in, const int* in_sizes, int n_in, void* d_out, int out_size, void* d_ws, size_t ws_size, hipStream_t stream) {
    static int grid = 0;
    if (grid == 0) {
        if (n_in != 20 || in_sizes[0] != M * D || out_size != M * D || ws_size < WS_END) { fprintf(stderr, "kernel_launch: unexpected shapes (n_in %d, in0 %d, out %d, ws %zu < %zu)\n", n_in, n_in > 0 ? in_sizes[0] : -1, out_size, ws_size, (size_t)WS_END); grid = -1; return; }
        int dev = 0, cus = 0, per_cu = 0;
        if (hipGetDevice(&dev) != hipSuccess || hipDeviceGetAttribute(&cus, hipDeviceAttributeMultiprocessorCount, dev) != hipSuccess) { grid = -1; return; }
        if (hipFuncSetAttribute((const void*)fwd_kernel, hipFuncAttributeMaxDynamicSharedMemorySize, LDS_BYTES) != hipSuccess) { fprintf(stderr, "kernel_launch: hipFuncSetAttribute failed\n"); grid = -1; return; }
        if (hipOccupancyMaxActiveBlocksPerMultiprocessor(&per_cu, (const void*)fwd_kernel, NTHREADS, LDS_BYTES) != hipSuccess || per_cu < 1) { fprintf(stderr, "kernel_launch: occupancy query says %d\n", per_cu); per_cu = 1; }
        (void)hipGetLastError();
        grid = cus * 1;
        if (grid > NPANEL) grid = NPANEL;
    }
    if (grid < 0) return;
    Args a{};
    for (int i = 0; i < 20; ++i) a.in[i] = (const float*)d_in[i];
    a.out = (float*)d_out; a.ws = (unsigned char*)d_ws;
#if MK_N_LAUNCHES == 1
    a.ph_lo = 0; a.ph_hi = 3;
    void* args[] = {&a};
    hipError_t e = hipLaunchCooperativeKernel((const void*)fwd_kernel, dim3(grid), dim3(NTHREADS), args, LDS_BYTES, stream);
    if (e != hipSuccess) fprintf(stderr, "kernel_launch: cooperative launch failed: %s (grid %d)\n", hipGetErrorString(e), grid);
#else
    for (int li = 0; li < 3; ++li) { a.ph_lo = li; a.ph_hi = li + 1; hipLaunchKernelGGL(fwd_kernel, dim3(grid), dim3(NTHREADS), LDS_BYTES, stream, a); }
#endif
}
```
